# Optimizing an MI355X kernel written in HIP

```python
import numpy as np
import jax
import jax.numpy as jnp
from jax import lax

D_MODEL = 1024
BATCH = 32
SEQ = 256
DEPTH = 2
DEC_BATCH = 2
DEC_SEQ = 1024
PAST_LEN = 256

GRID_W = 64
HEAD_DIM = 64
H_A = 8
G_B = 4
H_C = 4
W_A = H_A * HEAD_DIM
W_B = G_B * HEAD_DIM
W_C = H_C * HEAD_DIM
D_MIX = W_A + W_B + W_C
WIN_ROWS = 8
WIN_COLS = 16
CHUNK = 128
LORA_W = 32
LORA_A = 32
LORA_G = 64
D_FF = 2816
N_MOD = 9
EPS = 1e-6
GN_EPS = 64e-5
IN_SIZES = (W_A, W_A, W_A, W_B, W_B, W_C, W_C, W_C, 2 * LORA_W, 2 * LORA_A, LORA_G)
D_IN = sum(IN_SIZES)

kernel_name = 'hybrid_flow_na_sgu_rwkv7_step'


def rmsnorm(x, g):
    xf = x.astype(jnp.float32)
    y = xf * lax.rsqrt(jnp.mean(xf * xf, -1, keepdims=True) + EPS)
    return (y * g.astype(jnp.float32)).astype(x.dtype)


def layernorm(x, w, b):
    xf = x.astype(jnp.float32)
    mu = jnp.mean(xf, -1, keepdims=True)
    var = jnp.mean(jnp.square(xf - mu), -1, keepdims=True)
    y = (xf - mu) * lax.rsqrt(var + EPS) * w.astype(jnp.float32) + b.astype(jnp.float32)
    return y.astype(x.dtype)


def heads(t, h):
    return t.reshape(t.shape[0], t.shape[1], h, HEAD_DIM)


def adaln(cvec, w_ada, b_ada):
    m = jax.nn.silu(cvec) @ w_ada + b_ada
    return m.reshape(cvec.shape[0], N_MOD, D_MODEL)


def modulated(x, mod, g, i):
    return rmsnorm(x, g) * (1 + mod[:, 3 * i + 1][:, None, :]) + mod[:, 3 * i][:, None, :]


def swiglu(h, w_gu, w_down):
    gt, up = jnp.split(h @ w_gu, 2, axis=-1)
    return (jax.nn.silu(gt) * up) @ w_down


def split_in(h, w_in):
    z = h @ w_in
    idx = [int(i) for i in np.cumsum(IN_SIZES)[:-1]]
    return jnp.split(z, idx, axis=-1)


def context_attention(q, k, v):
    B, C = q.shape[:2]
    qb = jnp.moveaxis(q.reshape(B, C // CHUNK, CHUNK, H_A, HEAD_DIM), 1, 0)
    scale = HEAD_DIM ** -0.5

    def block(qi):
        s = jnp.einsum('bqhd,bkhd->bhqk', qi, k).astype(jnp.float32) * scale
        p = jax.nn.softmax(s, axis=-1).astype(v.dtype)
        return jnp.einsum('bhqk,bkhd->bqhd', p, v)

    o = lax.map(block, qb)
    return jnp.moveaxis(o, 0, 1).reshape(B, C, H_A, HEAD_DIM)


def neighbourhood_attention(q, k, v, k_ctx, v_ctx, rpb):
    B, T = q.shape[:2]
    rows = T // GRID_W
    wr = min(WIN_ROWS, rows)
    qg = q.reshape(B, rows, GRID_W, H_A, HEAD_DIM)
    kg = k.reshape(B, rows, GRID_W, H_A, HEAD_DIM)
    vg = v.reshape(B, rows, GRID_W, H_A, HEAD_DIM)
    cols = np.arange(GRID_W)
    cs = np.clip(cols - WIN_COLS // 2, 0, GRID_W - WIN_COLS)
    col_ok = (cols[None, :] >= cs[:, None]) & (cols[None, :] < cs[:, None] + WIN_COLS)
    dc = np.clip(cols[None, :] - cols[:, None], -(WIN_COLS - 1), WIN_COLS - 1) + WIN_COLS - 1
    rpb_c = rpb[:, :, dc]
    neg = jnp.asarray(np.where(col_ok, 0.0, -1e30), jnp.float32)
    scale = HEAD_DIM ** -0.5
    n_loc = wr * GRID_W

    def row(r):
        rs = jnp.clip(r - wr // 2, 0, rows - wr)
        qr = lax.dynamic_index_in_dim(qg, r, axis=1, keepdims=False)
        kb = lax.dynamic_slice_in_dim(kg, rs, wr, axis=1).reshape(B, n_loc, H_A, HEAD_DIM)
        vb = lax.dynamic_slice_in_dim(vg, rs, wr, axis=1).reshape(B, n_loc, H_A, HEAD_DIM)
        dr = rs + jnp.arange(wr) - r + WIN_ROWS - 1
        bias = jnp.transpose(jnp.take(rpb_c, dr, axis=1), (0, 2, 1, 3)).astype(jnp.float32)
        bias = (bias + neg[None, :, None, :]).reshape(H_A, GRID_W, n_loc)
        s_loc = jnp.einsum('bqhd,bkhd->bhqk', qr, kb).astype(jnp.float32) * scale + bias
        s_ctx = jnp.einsum('bqhd,bkhd->bhqk', qr, k_ctx).astype(jnp.float32) * scale
        p = jax.nn.softmax(jnp.concatenate([s_loc, s_ctx], axis=-1), axis=-1).astype(v.dtype)
        return (jnp.einsum('bhqk,bkhd->bqhd', p[..., :n_loc], vb)
                + jnp.einsum('bhqk,bkhd->bqhd', p[..., n_loc:], v_ctx))

    o = lax.map(row, jnp.arange(rows))
    return jnp.moveaxis(o, 0, 1).reshape(B, T, H_A, HEAD_DIM)


def spatial_gating(u, v, lp):
    B, T, _ = u.shape
    vn = layernorm(v, lp['sgu_ln_w'], lp['sgu_ln_b']).reshape(B, T // CHUNK, CHUNK, G_B, HEAD_DIM)
    mixed = jnp.einsum('gpq,bnqgd->bnpgd', lp['sgu_w_s'], vn) + lp['sgu_b_s'].T[None, None, :, :, None]
    return u * mixed.reshape(B, T, W_B)


def rwkv7_scan(s0, r, w, k, v, a, b, reverse):
    xs = tuple(jnp.moveaxis(t, 1, 0) for t in (r, w, k, v, a, b))

    def step(S, inp):
        rt, wt, kt, vt, at, bt = inp
        sa = jnp.einsum('bhvk,bhk->bhv', S, at)
        S = S * wt[:, :, None, :] + sa[..., None] * bt[:, :, None, :] + vt[..., None] * kt[:, :, None, :]
        return S, jnp.einsum('bhvk,bhk->bhv', S, rt)

    s_fin, y = lax.scan(step, s0, xs, reverse=reverse)
    return jnp.moveaxis(y, 0, 1), s_fin


def rwkv7_bidir(r, k, v, wlo, alo, glo, s0_f, s0_b, lp):
    B, T, _ = r.shape
    rh, kh, vh = heads(r, H_C), heads(k, H_C), heads(v, H_C)
    kkf = heads(k * lp['rwkv_k_k'], H_C).astype(jnp.float32)
    kk = (kkf * lax.rsqrt(jnp.sum(kkf * kkf, -1, keepdims=True) + EPS)).astype(k.dtype)
    w = lp['rwkv_w0'] + jnp.einsum('btdr,drc->btdc', jnp.tanh(wlo.reshape(B, T, 2, LORA_W)), lp['rwkv_w2'])
    decay = jnp.exp(-jnp.exp(-jax.nn.softplus(-w) - 0.5))
    a = jax.nn.sigmoid(lp['rwkv_a0'] + jnp.einsum('btdr,drc->btdc', alo.reshape(B, T, 2, LORA_A), lp['rwkv_a2']))
    kmod = k[:, :, None, :] * (1 + (a - 1) * lp['rwkv_k_a'])
    y_f, s_f = rwkv7_scan(s0_f, rh, heads(decay[:, :, 0], H_C), heads(kmod[:, :, 0], H_C), vh,
                          -kk, kk * heads(a[:, :, 0], H_C), False)
    y_b, s_b = rwkv7_scan(s0_b, rh, heads(decay[:, :, 1], H_C), heads(kmod[:, :, 1], H_C), vh,
                          -kk, kk * heads(a[:, :, 1], H_C), True)
    yf = (y_f + y_b).astype(jnp.float32)
    mu = jnp.mean(yf, -1, keepdims=True)
    var = jnp.mean(jnp.square(yf - mu), -1, keepdims=True)
    y = ((yf - mu) * lax.rsqrt(var + GN_EPS)).astype(r.dtype).reshape(B, T, W_C)
    y = y * lp['rwkv_ln_w'] + lp['rwkv_ln_b']
    bonus = (jnp.sum(rh * kh * lp['rwkv_r_k'], -1, keepdims=True) * vh).reshape(B, T, W_C)
    g = jax.nn.sigmoid(glo) @ lp['rwkv_g2']
    return (y + bonus) * g, s_f, s_b


def token_mixing(h, lp, cache):
    B, T, _ = h.shape
    qa, ka, va, ub, vb, rc, kc, vc, wlo, alo, glo = split_in(h, lp['w_in'])
    qa, ka, va = heads(qa, H_A), heads(ka, H_A), heads(va, H_A)
    if cache is None:
        oa = context_attention(qa, ka, va)
        s0 = jnp.zeros((B, H_C, HEAD_DIM, HEAD_DIM), h.dtype)
        s0_f, s0_b = s0, s0
    else:
        k_ctx, v_ctx, st = cache
        oa = neighbourhood_attention(qa, ka, va, k_ctx, v_ctx, lp['na_rpb'])
        s0_f, s0_b = st[:, 0], st[:, 1]
    ob = spatial_gating(ub, vb, lp)
    oc, s_f, s_b = rwkv7_bidir(rc, kc, vc, wlo, alo, glo, s0_f, s0_b, lp)
    o = jnp.concatenate([oa.reshape(B, T, W_A), ob, oc], axis=-1) @ lp['w_out']
    return o, ka, va, jnp.stack([s_f, s_b], axis=1)


def trunk_layer(x, mod, lp, cache):
    h = modulated(x, mod, lp['norm_pre'][0], 0)
    f = swiglu(h, lp['ffn_w_gu'][0], lp['ffn_w_down'][0])
    x = x + 0.5 * mod[:, 2][:, None, :] * rmsnorm(f, lp['norm_post'][0])
    h = modulated(x, mod, lp['norm_pre'][1], 1)
    o, k_new, v_new, st_new = token_mixing(h, lp, cache)
    x = x + mod[:, 5][:, None, :] * rmsnorm(o, lp['norm_post'][1])
    h = modulated(x, mod, lp['norm_pre'][2], 2)
    f = swiglu(h, lp['ffn_w_gu'][1], lp['ffn_w_down'][1])
    x = x + 0.5 * mod[:, 8][:, None, :] * rmsnorm(f, lp['norm_post'][2])
    return x, k_new, v_new, st_new


def setup_inputs(seed: int = 0) -> dict:
    key = jax.random.key(seed)
    ks = iter(jax.random.split(key, 40))

    def nrm(shape, scale):
        return jax.random.normal(next(ks), shape, jnp.float32) * scale

    def gain(shape):
        return 1.0 + nrm(shape, 0.01)

    L = DEPTH
    return {
        'x_prompt': nrm((BATCH, SEQ, D_MODEL), 1.0),
        'x_sample': nrm((DEC_BATCH, DEC_SEQ, D_MODEL), 1.0),
        'cache_k_ctx': nrm((DEC_BATCH, L, PAST_LEN, H_A, HEAD_DIM), 1.0),
        'cache_v_ctx': nrm((DEC_BATCH, L, PAST_LEN, H_A, HEAD_DIM), 1.0),
        'state_rwkv': nrm((DEC_BATCH, L, 2, H_C, HEAD_DIM, HEAD_DIM), 0.5),
        'c': nrm((DEC_BATCH, D_MODEL), 1.0),
        'c_ctx': nrm((D_MODEL,), 1.0),
        'w_ada': nrm((L, D_MODEL, N_MOD * D_MODEL), 0.5 * D_MODEL ** -0.5),
        'b_ada': nrm((L, N_MOD * D_MODEL), 0.01),
        'norm_pre': gain((L, 3, D_MODEL)),
        'norm_post': gain((L, 3, D_MODEL)),
        'ffn_w_gu': nrm((L, 2, D_MODEL, 2 * D_FF), D_MODEL ** -0.5),
        'ffn_w_down': nrm((L, 2, D_FF, D_MODEL), D_FF ** -0.5),
        'w_in': nrm((L, D_MODEL, D_IN), D_MODEL ** -0.5),
        'w_out': nrm((L, D_MIX, D_MODEL), D_MIX ** -0.5),
        'na_rpb': nrm((L, H_A, 2 * WIN_ROWS - 1, 2 * WIN_COLS - 1), 0.1),
        'sgu_ln_w': gain((L, W_B)),
        'sgu_ln_b': nrm((L, W_B), 0.01),
        'sgu_w_s': nrm((L, G_B, CHUNK, CHUNK), CHUNK ** -0.5),
        'sgu_b_s': 1.0 + nrm((L, G_B, CHUNK), 0.1),
        'rwkv_w0': nrm((L, 2, W_C), 0.5),
        'rwkv_w2': nrm((L, 2, LORA_W, W_C), 0.1 * LORA_W ** -0.5),
        'rwkv_a0': nrm((L, 2, W_C), 0.5),
        'rwkv_a2': nrm((L, 2, LORA_A, W_C), 0.1 * LORA_A ** -0.5),
        'rwkv_g2': nrm((L, LORA_G, W_C), LORA_G ** -0.5),
        'rwkv_k_k': 0.85 + nrm((L, W_C), 0.05),
        'rwkv_k_a': gain((L, W_C)),
        'rwkv_r_k': nrm((L, H_C, HEAD_DIM), 0.1),
        'rwkv_ln_w': gain((L, W_C)),
        'rwkv_ln_b': nrm((L, W_C), 0.01),
    }


def reference(x_prompt, x_sample, cache_k_ctx, cache_v_ctx, state_rwkv, c, c_ctx,
              w_ada, b_ada, norm_pre, norm_post, ffn_w_gu, ffn_w_down, w_in, w_out, na_rpb,
              sgu_ln_w, sgu_ln_b, sgu_w_s, sgu_b_s, rwkv_w0, rwkv_w2, rwkv_a0, rwkv_a2, rwkv_g2,
              rwkv_k_k, rwkv_k_a, rwkv_r_k, rwkv_ln_w, rwkv_ln_b):
    xp, xs = x_prompt, x_sample
    ks_new, vs_new, st_new = [], [], []
    for l in range(DEPTH):
        lp = {
            'norm_pre': norm_pre[l], 'norm_post': norm_post[l],
            'ffn_w_gu': ffn_w_gu[l], 'ffn_w_down': ffn_w_down[l],
            'w_in': w_in[l], 'w_out': w_out[l], 'na_rpb': na_rpb[l],
            'sgu_ln_w': sgu_ln_w[l], 'sgu_ln_b': sgu_ln_b[l], 'sgu_w_s': sgu_w_s[l], 'sgu_b_s': sgu_b_s[l],
            'rwkv_w0': rwkv_w0[l], 'rwkv_w2': rwkv_w2[l], 'rwkv_a0': rwkv_a0[l], 'rwkv_a2': rwkv_a2[l],
            'rwkv_g2': rwkv_g2[l], 'rwkv_k_k': rwkv_k_k[l], 'rwkv_k_a': rwkv_k_a[l], 'rwkv_r_k': rwkv_r_k[l],
            'rwkv_ln_w': rwkv_ln_w[l], 'rwkv_ln_b': rwkv_ln_b[l],
        }
        mod_ctx = adaln(c_ctx[None, :], w_ada[l], b_ada[l])
        mod_lat = adaln(c, w_ada[l], b_ada[l])
        xp, k_l, v_l, s_l = trunk_layer(xp, mod_ctx, lp, None)
        ks_new.append(k_l)
        vs_new.append(v_l)
        st_new.append(s_l)
        xs, _, _, _ = trunk_layer(xs, mod_lat, lp, (cache_k_ctx[:, l], cache_v_ctx[:, l], state_rwkv[:, l]))
    new_k_ctx = jnp.stack(ks_new, axis=1)
    new_v_ctx = jnp.stack(vs_new, axis=1)
    new_state_rwkv = jnp.stack(st_new, axis=1)
    return (xp, xs, new_k_ctx, new_v_ctx, new_state_rwkv)
```

```cpp
#include <hip/hip_runtime.h>
#include <hip/hip_cooperative_groups.h>
#include <cstdio>
namespace cg = cooperative_groups;

#ifndef REPMASK
#define REPMASK 0x0
#endif
#ifndef PROBE_MODE
#define PROBE_MODE 0
#endif
#ifndef MIXREP
#define MIXREP 0
#endif
#ifndef COOP
#define COOP 1
#endif

typedef unsigned short bfraw;
typedef __attribute__((ext_vector_type(8))) short bf16x8;
typedef __attribute__((ext_vector_type(4))) float f32x4;
typedef __attribute__((ext_vector_type(2))) float f32x2;

constexpr int D = 1024, NTOK = 10240, NCTX = 8192, DFF = 2816, DIN = 3008, DINP = 3072;
constexpr int NPREP = 1280;
constexpr float EPS = 1e-6f, GN_EPS = 64e-5f;

struct P {
  const float *x_prompt, *x_sample, *cache_k, *cache_v, *state, *c, *c_ctx, *w_ada, *b_ada, *norm_pre, *norm_post,
      *w_gu, *w_down, *w_in, *w_out, *rpb, *sgu_ln_w, *sgu_ln_b, *sgu_w_s, *sgu_b_s, *w0, *w2, *a0, *a2, *g2, *k_k,
      *k_a, *r_k, *ln_w, *ln_b;
  float *X, *out_k, *out_v, *out_state;
  bfraw *wt_gu, *wt_down, *wt_in, *wt_out;
  float* mods;
  bfraw* H;
  float* Y;
  float* Z;
  bfraw* ACT;
  float* F;
  bfraw* O;
  float* PREP;
  unsigned* bar;
  bfraw* XB;
  bfraw* QB;
  bfraw* UB;
};

__device__ __forceinline__ int otid() { int t = threadIdx.x; asm volatile("" : "+v"(t)); return t; }
__device__ __forceinline__ int obid() { int b = blockIdx.x; asm volatile("" : "+s"(b)); return b; }
__device__ __forceinline__ unsigned f2bf(float f) {
  unsigned u = __float_as_uint(f);
  u += 0x7fffu + ((u >> 16) & 1u);
  return u >> 16;
}
__device__ __forceinline__ unsigned pack2(float a, float b) { return f2bf(a) | (f2bf(b) << 16); }
__device__ __forceinline__ uint4 pack8(float4 a, float4 b) {
  uint4 r;
  r.x = pack2(a.x, a.y); r.y = pack2(a.z, a.w); r.z = pack2(b.x, b.y); r.w = pack2(b.z, b.w);
  return r;
}
__device__ __forceinline__ float sigmoidf_(float x) { return 1.f / (1.f + __expf(-x)); }

template <int CTRL>
__device__ __forceinline__ float dpp(float x) {
  return __int_as_float(__builtin_amdgcn_update_dpp(0, __float_as_int(x), CTRL, 0xF, 0xF, true));
}
__device__ __forceinline__ float sum8(float x) {
  x += dpp<0xB1>(x); x += dpp<0x4E>(x); x += dpp<0x141>(x);
  return x;
}
__device__ __forceinline__ float sum16(float x) {
  x += dpp<0xB1>(x); x += dpp<0x4E>(x); x += dpp<0x141>(x); x += dpp<0x140>(x);
  return x;
}
__device__ __forceinline__ float max16(float x) {
  x = fmaxf(x, dpp<0xB1>(x)); x = fmaxf(x, dpp<0x4E>(x)); x = fmaxf(x, dpp<0x141>(x)); x = fmaxf(x, dpp<0x140>(x));
  return x;
}
__device__ __forceinline__ float sum64(float x) {
#pragma unroll
  for (int o = 32; o > 0; o >>= 1) x += __shfl_xor(x, o);
  return x;
}
__device__ __forceinline__ float bcast(float x, int srclane) {
  return __int_as_float(__builtin_amdgcn_readlane(__float_as_int(x), srclane));
}
__device__ __forceinline__ f32x4 mfma16(bf16x8 a, bf16x8 b, f32x4 c) {
  return __builtin_amdgcn_mfma_f32_16x16x32_bf16(a, b, c, 0, 0, 0);
}
__device__ __forceinline__ bf16x8 as_bf8(uint4 v) {
  union { uint4 u; bf16x8 b; } x; x.u = v; return x.b;
}

#define XB_TMO 128
#define XB_XCNT(j) (256 + 64 * (j))
#define XB_XSUB(j) (1280 + 64 * (j))
#define XB_XGEN(j) (2304 + 64 * (j))
#define XB_TOP 3328
#define XB_TOPGEN 3392
#define XCD_BAR_WORDS 3456
#define XB_SPIN_CAP (1u << 22)
#define LAS __attribute__((address_space(3)))
__device__ __forceinline__ unsigned xb_ld(unsigned* p) { return __hip_atomic_load(p, __ATOMIC_RELAXED, __HIP_MEMORY_SCOPE_AGENT); }
__device__ __forceinline__ unsigned xb_add(unsigned* p, unsigned v) { return __hip_atomic_fetch_add(p, v, __ATOMIC_RELAXED, __HIP_MEMORY_SCOPE_AGENT); }
__device__ __forceinline__ unsigned xb_xcc_id() { return (unsigned)__builtin_amdgcn_s_getreg((3 << 11) | 20) & 0xFu; }
#define XB_SPIN(cond, bar) do { unsigned _sp = 0; while (cond) { __builtin_amdgcn_s_sleep(1); \
    if ((++_sp & 255u) == 0u) { if (xb_ld(&(bar)[XB_TMO])) break; if (_sp > XB_SPIN_CAP) { atomicAdd(&(bar)[XB_TMO], 1u); break; } } } } while (0)
struct XcdBarrier { unsigned* bar; unsigned x; volatile LAS unsigned* st; };
__device__ __forceinline__ XcdBarrier xcd_barrier_post(unsigned* bar, volatile LAS unsigned* st) {
  XcdBarrier b; b.bar = bar; b.x = xb_xcc_id(); b.st = st;
  if (threadIdx.x == 0) (void)xb_add(&bar[XB_XCNT(b.x)], 1u);
  return b;
}
__device__ __forceinline__ void xcd_barrier_complete(unsigned* bar, unsigned x, unsigned& nloc, unsigned& nx) {
  const unsigned G = gridDim.x * gridDim.y * gridDim.z;
  unsigned sum, cnt, mine, sp = 0u;
  for (;;) {
    sum = 0u; cnt = 0u; mine = 0u;
#pragma unroll
    for (unsigned j = 0; j < 16; ++j) { const unsigned c = xb_ld(&bar[XB_XCNT(j)]); sum += c; cnt += (c > 0u) ? 1u : 0u; mine = (j == x) ? c : mine; }
    if (sum == G) break;
    __builtin_amdgcn_s_sleep(1);
    if ((++sp & 255u) == 0u) { if (xb_ld(&bar[XB_TMO])) break; if (sp > XB_SPIN_CAP) { atomicAdd(&bar[XB_TMO], 1u); break; } }
  }
  nloc = mine > 0u ? mine : 1u; nx = cnt > 0u ? cnt : 1u;
}
__device__ __forceinline__ void xcd_barrier(const XcdBarrier& b) {
  asm volatile("s_waitcnt vmcnt(0)" ::: "memory");
  __syncthreads();
  if (threadIdx.x == 0) {
    unsigned* bar = b.bar;
    __builtin_amdgcn_s_waitcnt(0);
    unsigned nloc = b.st[0], nx = b.st[1];
    if (nloc == 0u) { xcd_barrier_complete(bar, b.x, nloc, nx); b.st[0] = nloc; b.st[1] = nx; }
    const unsigned old = xb_add(&bar[XB_XSUB(b.x)], 1u);
    const unsigned gen = old / nloc;
    if (old + 1u == (gen + 1u) * nloc) {
      __builtin_amdgcn_fence(__ATOMIC_RELEASE, "agent");
      asm volatile("s_waitcnt vmcnt(0)" ::: "memory");
      const unsigned og = xb_add(&bar[XB_TOP], 1u);
      const unsigned tg = og / nx;
      if (og + 1u == (tg + 1u) * nx) xb_add(&bar[XB_TOPGEN], 1u);
      else XB_SPIN(xb_ld(&bar[XB_TOPGEN]) == tg, bar);
      __builtin_amdgcn_fence(__ATOMIC_ACQUIRE, "agent");
      xb_add(&bar[XB_XGEN(b.x)], 1u);
      asm volatile("s_waitcnt vmcnt(0)" ::: "memory");
    } else {
      XB_SPIN(xb_ld(&bar[XB_XGEN(b.x)]) == gen, bar);
      __builtin_amdgcn_fence(__ATOMIC_ACQUIRE, "agent");
      asm volatile("s_waitcnt vmcnt(0)" ::: "memory");
    }
  }
  __syncthreads();
}

__device__ void transpose_item(const P& p, int i, char* smem) {
  const float* src; bfraw* dst; int K, N, tiles_n, t;
  if (i < 5632) { int m = i / 1408; t = i % 1408; K = 1024; N = 5632; tiles_n = 88;
    src = p.w_gu + (size_t)m * 1024 * 5632; dst = p.wt_gu + (size_t)m * 5632 * 1024; }
  else if (i < 8448) { int j = i - 5632; int m = j / 704; t = j % 704; K = 2816; N = 1024; tiles_n = 16;
    src = p.w_down + (size_t)m * 2816 * 1024; dst = p.wt_down + (size_t)m * 1024 * 2816; }
  else if (i < 9984) { int j = i - 8448; int m = j / 768; t = j % 768; K = 1024; N = 3008; tiles_n = 48;
    src = p.w_in + (size_t)m * 1024 * 3008; dst = p.wt_in + (size_t)m * DINP * 1024; }
  else { int j = i - 9984; int m = j / 256; t = j % 256; K = 1024; N = 1024; tiles_n = 16;
    src = p.w_out + (size_t)m * 1024 * 1024; dst = p.wt_out + (size_t)m * 1024 * 1024; }
  const int k0 = (t / tiles_n) * 64, n0 = (t % tiles_n) * 64;
  float* tile = (float*)smem;
  const int tid = otid();
#pragma unroll
  for (int ii = 0; ii < 4; ++ii) {
    int kk = (tid >> 4) + 16 * ii, n4 = (tid & 15) * 4, n = n0 + n4;
    float4 v = make_float4(0.f, 0.f, 0.f, 0.f);
    if (n < N) v = *(const float4*)(src + (size_t)(k0 + kk) * N + n);
    float* tp = tile + kk * 65 + n4;
    tp[0] = v.x; tp[1] = v.y; tp[2] = v.z; tp[3] = v.w;
  }
  __syncthreads();
  {
    int n = tid >> 2, ks = (tid & 3) * 16;
    float v[16];
#pragma unroll
    for (int j = 0; j < 16; ++j) v[j] = tile[(ks + j) * 65 + n];
    uint4 a, b;
    a.x = pack2(v[0], v[1]); a.y = pack2(v[2], v[3]); a.z = pack2(v[4], v[5]); a.w = pack2(v[6], v[7]);
    b.x = pack2(v[8], v[9]); b.y = pack2(v[10], v[11]); b.z = pack2(v[12], v[13]); b.w = pack2(v[14], v[15]);
    bfraw* dp = dst + (size_t)(n0 + n) * K + k0 + ks;
    *(uint4*)dp = a; *(uint4*)(dp + 8) = b;
  }
  __syncthreads();
}

__device__ void adaln_item(const P& p, int j, char* smem) {
  const int l = j / 144, n0 = (j % 144) * 64, tid = otid();
  float* sc = (float*)smem;
  float* red = sc + 3072;
  for (int idx = tid; idx < 3072; idx += 256) {
    int b = idx >> 10, k = idx & 1023;
    float cv = (b == 0) ? p.c_ctx[k] : p.c[(b - 1) * 1024 + k];
    sc[idx] = cv / (1.f + __expf(-cv));
  }
  __syncthreads();
  const int kq = tid >> 4, c4 = tid & 15;
  float acc[3][4];
#pragma unroll
  for (int b = 0; b < 3; ++b)
#pragma unroll
    for (int e = 0; e < 4; ++e) acc[b][e] = 0.f;
  const float* wp = p.w_ada + (size_t)l * 1024 * 9216 + n0 + c4 * 4;
#pragma unroll 16
  for (int i = 0; i < 64; ++i) {
    int k = kq + 16 * i;
    float4 w = *(const float4*)(wp + (size_t)k * 9216);
#pragma unroll
    for (int b = 0; b < 3; ++b) {
      float s = sc[b * 1024 + k];
      acc[b][0] += s * w.x; acc[b][1] += s * w.y; acc[b][2] += s * w.z; acc[b][3] += s * w.w;
    }
  }
#pragma unroll
  for (int b = 0; b < 3; ++b)
#pragma unroll
    for (int e = 0; e < 4; ++e) red[(kq * 3 + b) * 64 + c4 * 4 + e] = acc[b][e];
  __syncthreads();
  if (tid < 192) {
    int b = tid >> 6, col = tid & 63;
    float s = 0.f;
#pragma unroll
    for (int q = 0; q < 16; ++q) s += red[(q * 3 + b) * 64 + col];
    const int n = n0 + col, idx = n >> 10, c = n & 1023, sub = idx / 3, kind = idx - 3 * sub;
    float v = s + p.b_ada[l * 9216 + n];
    if (kind == 1) v = p.norm_pre[(size_t)(l * 3 + sub) * 1024 + c] * (1.f + v);
    else if (kind == 2) v = ((sub == 1) ? 1.f : 0.5f) * v * p.norm_post[(size_t)(l * 3 + sub) * 1024 + c];
    p.mods[(size_t)(l * 3 + b) * 9216 + n] = v;
  }
  __syncthreads();
}

__device__ __forceinline__ int early_transpose_id(int e) {
  return e < 1408 ? e : (e < 2112 ? 5632 + (e - 1408) : 8448 + (e - 2112));
}
__device__ __forceinline__ int late_transpose_id(int k) {
  return k < 4224 ? 1408 + k : (k < 6336 ? 6336 + (k - 4224) : (k < 7104 ? 9216 + (k - 6336) : 9984 + (k - 7104)));
}
constexpr int N_EARLY_T = 2880, N_LATE_T = 7616;

__device__ void phase_prologue(const P& p, char* smem, int* s_item) {
  const int nitems = 288 + N_EARLY_T;
  unsigned* ctr = p.bar + XCD_BAR_WORDS + 40;
  for (;;) {
    __syncthreads();
    if (otid() == 0) *s_item = (int)atomicAdd(ctr, 1u);
    __syncthreads();
    const int i = *s_item;
    if (i >= nitems) break;
    if (i < 288) adaln_item(p, i, smem);
    else transpose_item(p, early_transpose_id(i - 288), smem);
  }
}

__device__ __forceinline__ void unpack8(const uint4 u, float4& a, float4& b) {
  a = make_float4(__uint_as_float(u.x << 16), __uint_as_float(u.x & 0xffff0000u), __uint_as_float(u.y << 16), __uint_as_float(u.y & 0xffff0000u));
  b = make_float4(__uint_as_float(u.z << 16), __uint_as_float(u.z & 0xffff0000u), __uint_as_float(u.w << 16), __uint_as_float(u.w & 0xffff0000u));
}
__device__ void phase_rowop(const P& p, int l_post, int i_post, int l_next, int i_next) {
  const int lane = otid() & 63;
  const int gw = (obid() * 256 + otid()) >> 6, nw = gridDim.x * 4;
  for (int row = gw; row < NTOK; row += nw) {
    const int ms = row < NCTX ? 0 : 1 + ((row - NCTX) >> 10);
    float4 x[4];
    if (i_post < 0) {
      const float4* src = (const float4*)(row < NCTX ? p.x_prompt + (size_t)row * D : p.x_sample + (size_t)(row - NCTX) * D);
#pragma unroll
      for (int j = 0; j < 2; ++j) { x[2 * j] = src[j * 128 + lane * 2]; x[2 * j + 1] = src[j * 128 + lane * 2 + 1]; }
    } else {
      const uint4* xs = (const uint4*)(p.XB + (size_t)row * D);
      const uint4* fs = (const uint4*)((const bfraw*)p.F + (size_t)row * D);
      float4 f[4];
      float ss = 0.f;
#pragma unroll
      for (int j = 0; j < 2; ++j) {
        const uint4 xb = xs[j * 64 + lane], fb = fs[j * 64 + lane];
        unpack8(xb, x[2 * j], x[2 * j + 1]);
        unpack8(fb, f[2 * j], f[2 * j + 1]);
      }
#pragma unroll
      for (int j = 0; j < 4; ++j) ss += f[j].x * f[j].x + f[j].y * f[j].y + f[j].z * f[j].z + f[j].w * f[j].w;
      ss = sum64(ss);
      const float rstd = rsqrtf(ss * (1.f / 1024.f) + EPS);
      const float4* gt = (const float4*)(p.mods + (size_t)(l_post * 3 + ms) * 9216 + (3 * i_post + 2) * 1024);
#pragma unroll
      for (int j = 0; j < 4; ++j) {
        const float4 g = gt[(j >> 1) * 128 + lane * 2 + (j & 1)];
        x[j].x += g.x * (f[j].x * rstd);
        x[j].y += g.y * (f[j].y * rstd);
        x[j].z += g.z * (f[j].z * rstd);
        x[j].w += g.w * (f[j].w * rstd);
      }
    }
    if (i_next < 0) {
      float4* xd = (float4*)(p.X + (size_t)row * D);
#pragma unroll
      for (int j = 0; j < 4; ++j) xd[(j >> 1) * 128 + lane * 2 + (j & 1)] = x[j];
    } else {
      uint4* xd = (uint4*)(p.XB + (size_t)row * D);
#pragma unroll
      for (int j = 0; j < 2; ++j) xd[j * 64 + lane] = pack8(x[2 * j], x[2 * j + 1]);
    }
    if (i_next >= 0) {
      float ss = 0.f;
#pragma unroll
      for (int j = 0; j < 4; ++j) ss += x[j].x * x[j].x + x[j].y * x[j].y + x[j].z * x[j].z + x[j].w * x[j].w;
      ss = sum64(ss);
      const float rstd = rsqrtf(ss * (1.f / 1024.f) + EPS);
      const float4* sh = (const float4*)(p.mods + (size_t)(l_next * 3 + ms) * 9216 + (3 * i_next) * 1024);
      const float4* sc = (const float4*)(p.mods + (size_t)(l_next * 3 + ms) * 9216 + (3 * i_next + 1) * 1024);
      uint4* hd = (uint4*)(p.H + (size_t)row * D);
#pragma unroll
      for (int j = 0; j < 2; ++j) {
        float4 h[2];
#pragma unroll
        for (int e = 0; e < 2; ++e) {
          const int q = j * 128 + lane * 2 + e;
          const float4 s = sh[q], c = sc[q];
          const float4 xv = x[2 * j + e];
          h[e] = make_float4(xv.x * rstd * c.x + s.x, xv.y * rstd * c.y + s.y, xv.z * rstd * c.z + s.z, xv.w * rstd * c.w + s.w);
        }
        hd[j * 64 + lane] = pack8(h[0], h[1]);
      }
    }
  }
}

enum { EPI_SWIGLU = 0, EPI_F32 = 1, EPI_Z = 2 };

template <int EPI, int MODE = 0>
__device__ __forceinline__ void gemm_tile(const P& p, const bfraw* __restrict__ A, const bfraw* __restrict__ WT,
                                          int K, int tm, int tn, int l, char* smem) {
  const int tid = otid(), lane = tid & 63, wid = tid >> 6;
  const int fr = lane & 15, fq = lane >> 4;
  const int wr = wid >> 1, wc = wid & 1;
  char* sA = smem;
  char* sB = smem + 16384;
  const int lr = tid >> 3, lc = tid & 7;
  const bfraw* ap = A + (size_t)(tm * 128 + lr) * K + lc * 8;
  const bfraw* bp;
  size_t bstep;
  const int pcol = 8 * ((lr & 15) >> 2) + (lr & 3);
  size_t bo1, bo2, bo3;
  if (EPI == EPI_SWIGLU) {
    bp = WT + (size_t)((lr >> 4) * DFF + tn * 64 + pcol) * K + lc * 8;
    bo1 = (size_t)4 * K; bo2 = (size_t)32 * K; bo3 = (size_t)36 * K;
  } else {
    bp = WT + (size_t)(tn * 128 + pcol + 4 * (lr >> 4)) * K + lc * 8;
    bo1 = (size_t)32 * K; bo2 = (size_t)64 * K; bo3 = (size_t)96 * K;
  }
  bstep = 0; (void)bstep;
  const size_t astep = (size_t)32 * K;
  const int wofs = lr * 128 + ((lc ^ ((lr >> 1) & 7)) << 4);

  f32x4 acc[4][4];
#pragma unroll
  for (int m = 0; m < 4; ++m)
#pragma unroll
    for (int n = 0; n < 4; ++n) acc[m][n] = (f32x4){0.f, 0.f, 0.f, 0.f};

  uint4 ra0, ra1, ra2, ra3, rb0, rb1, rb2, rb3;
#define GLOAD(ko)                                                                                      \
  ra0 = *(const uint4*)(ap + (ko)); ra1 = *(const uint4*)(ap + astep + (ko));                          \
  ra2 = *(const uint4*)(ap + 2 * astep + (ko)); ra3 = *(const uint4*)(ap + 3 * astep + (ko));          \
  rb0 = *(const uint4*)(bp + (ko)); rb1 = *(const uint4*)(bp + bo1 + (ko));                            \
  rb2 = *(const uint4*)(bp + bo2 + (ko)); rb3 = *(const uint4*)(bp + bo3 + (ko));
  GLOAD(0)
  const int nkt = K >> 6;
  const int sw = (fr >> 1) & 7;
  for (int kt = 0; kt < nkt; ++kt) {
    __syncthreads();
    *(uint4*)(sA + wofs) = ra0; *(uint4*)(sA + wofs + 4096) = ra1;
    *(uint4*)(sA + wofs + 8192) = ra2; *(uint4*)(sA + wofs + 12288) = ra3;
    *(uint4*)(sB + wofs) = rb0; *(uint4*)(sB + wofs + 4096) = rb1;
    *(uint4*)(sB + wofs + 8192) = rb2; *(uint4*)(sB + wofs + 12288) = rb3;
    __syncthreads();
    if (MODE != 1 && kt + 1 < nkt) {
      const int ko = (kt + 1) * 64;
      GLOAD(ko)
    }
#pragma unroll
    for (int s2 = 0; s2 < 2; ++s2) {
      bf16x8 af[4], bf[4];
      const int co = ((s2 * 4 + fq) ^ sw) << 4;
#pragma unroll
      for (int m = 0; m < 4; ++m) af[m] = *(const bf16x8*)(sA + (wr * 64 + m * 16 + fr) * 128 + co);
#pragma unroll
      for (int n = 0; n < 4; ++n) bf[n] = *(const bf16x8*)(sB + (wc * 64 + n * 16 + fr) * 128 + co);
#pragma unroll
      for (int m = 0; m < 4; ++m)
#pragma unroll
        for (int n = 0; n < 4; ++n) {
          if (MODE == 2) { asm volatile("" ::"v"(af[m]), "v"(bf[n])); }
          else acc[m][n] = mfma16(bf[n], af[m], acc[m][n]);
        }
    }
  }
#undef GLOAD
  const int row0 = tm * 128 + wr * 64 + fr;
  if (EPI == EPI_SWIGLU) {
#pragma unroll
    for (int m = 0; m < 4; ++m) {
      float4 a[2];
#pragma unroll
      for (int q = 0; q < 2; ++q) {
        const f32x4 g = acc[m][2 * q], u = acc[m][2 * q + 1];
        a[q] = make_float4(g[0] * __builtin_amdgcn_rcpf(1.f + __expf(-g[0])) * u[0], g[1] * __builtin_amdgcn_rcpf(1.f + __expf(-g[1])) * u[1],
                           g[2] * __builtin_amdgcn_rcpf(1.f + __expf(-g[2])) * u[2], g[3] * __builtin_amdgcn_rcpf(1.f + __expf(-g[3])) * u[3]);
      }
      *(uint4*)((MODE ? (bfraw*)p.PREP : p.ACT) + (size_t)(row0 + m * 16) * DFF + tn * 64 + wc * 32 + fq * 8) = pack8(a[0], a[1]);
    }
  } else if (EPI == EPI_F32) {
#pragma unroll
    for (int m = 0; m < 4; ++m)
#pragma unroll
      for (int g2 = 0; g2 < 2; ++g2) {
        const f32x4 lo = acc[m][2 * g2], hi = acc[m][2 * g2 + 1];
        *(uint4*)((bfraw*)p.F + (size_t)(row0 + m * 16) * D + tn * 128 + wc * 64 + g2 * 32 + fq * 8) =
            pack8(make_float4(lo[0], lo[1], lo[2], lo[3]), make_float4(hi[0], hi[1], hi[2], hi[3]));
      }
  } else {
#pragma unroll
    for (int g2 = 0; g2 < 2; ++g2) {
      const int col = tn * 128 + wc * 64 + g2 * 32 + fq * 8;
      if (col < DIN) {
#pragma unroll
        for (int m = 0; m < 4; ++m) {
          const int row = row0 + m * 16;
          if (col < 512) {
            const f32x4 lo = acc[m][2 * g2], hi = acc[m][2 * g2 + 1];
            *(uint4*)(p.QB + (size_t)row * 512 + col) = pack8(make_float4(lo[0], lo[1], lo[2], lo[3]), make_float4(hi[0], hi[1], hi[2], hi[3]));
          } else if (col >= 1536 && col < 2048) {
            const f32x4 lo = acc[m][2 * g2], hi = acc[m][2 * g2 + 1];
            *(uint4*)(p.UB + (size_t)row * 512 + (col - 1536)) = pack8(make_float4(lo[0], lo[1], lo[2], lo[3]), make_float4(hi[0], hi[1], hi[2], hi[3]));
          } else if (row < NCTX && col >= 512 && col < 1536) {
            const int b = row >> 8, t = row & 255;
            float* dst = ((col < 1024) ? p.out_k : p.out_v) + ((size_t)(b * 2 + l) * 256 + t) * 512 + (col & 511);
            *(f32x4*)dst = acc[m][2 * g2]; *(f32x4*)(dst + 4) = acc[m][2 * g2 + 1];
          } else {
            float* zp = p.Z + (size_t)row * DIN + col;
            *(f32x4*)zp = acc[m][2 * g2]; *(f32x4*)(zp + 4) = acc[m][2 * g2 + 1];
          }
        }
      }
    }
  }
}

__device__ __forceinline__ void gemm_tile_half(const P& p, const bfraw* __restrict__ A, const bfraw* __restrict__ WT,
                                               int K, int tm, int tn, int nh, char* smem) {
  const int tid = otid(), lane = tid & 63, wid = tid >> 6;
  const int fr = lane & 15, fq = lane >> 4;
  const int wr = wid >> 1, wc = wid & 1;
  char* sA = smem;
  char* sB = smem + 16384;
  const int lr = tid >> 3, lc = tid & 7;
  const bfraw* ap = A + (size_t)(tm * 128 + lr) * K + lc * 8;
  const bfraw* bp = WT + (size_t)(tn * 128 + nh * 64 + 8 * ((lr & 15) >> 2) + 4 * (lr >> 4) + (lr & 3)) * K + lc * 8;
  const size_t astep = (size_t)32 * K;
  const int wofs = lr * 128 + ((lc ^ ((lr >> 1) & 7)) << 4);
  f32x4 acc[4][2];
#pragma unroll
  for (int m = 0; m < 4; ++m)
#pragma unroll
    for (int n = 0; n < 2; ++n) acc[m][n] = (f32x4){0.f, 0.f, 0.f, 0.f};
  uint4 ra0, ra1, ra2, ra3, rb0, rb1;
#define GLOADH(ko)                                                                                     \
  ra0 = *(const uint4*)(ap + (ko)); ra1 = *(const uint4*)(ap + astep + (ko));                          \
  ra2 = *(const uint4*)(ap + 2 * astep + (ko)); ra3 = *(const uint4*)(ap + 3 * astep + (ko));          \
  rb0 = *(const uint4*)(bp + (ko)); rb1 = *(const uint4*)(bp + astep + (ko));
  GLOADH(0)
  const int nkt = K >> 6;
  const int sw = (fr >> 1) & 7;
  for (int kt = 0; kt < nkt; ++kt) {
    __syncthreads();
    *(uint4*)(sA + wofs) = ra0; *(uint4*)(sA + wofs + 4096) = ra1;
    *(uint4*)(sA + wofs + 8192) = ra2; *(uint4*)(sA + wofs + 12288) = ra3;
    *(uint4*)(sB + wofs) = rb0; *(uint4*)(sB + wofs + 4096) = rb1;
    __syncthreads();
    if (kt + 1 < nkt) {
      const int ko = (kt + 1) * 64;
      GLOADH(ko)
    }
#pragma unroll
    for (int s2 = 0; s2 < 2; ++s2) {
      bf16x8 af[4], bf[2];
      const int co = ((s2 * 4 + fq) ^ sw) << 4;
#pragma unroll
      for (int m = 0; m < 4; ++m) af[m] = *(const bf16x8*)(sA + (wr * 64 + m * 16 + fr) * 128 + co);
#pragma unroll
      for (int n = 0; n < 2; ++n) bf[n] = *(const bf16x8*)(sB + (wc * 32 + n * 16 + fr) * 128 + co);
#pragma unroll
      for (int m = 0; m < 4; ++m)
#pragma unroll
        for (int n = 0; n < 2; ++n) acc[m][n] = mfma16(bf[n], af[m], acc[m][n]);
    }
  }
#undef GLOADH
  const int row0 = tm * 128 + wr * 64 + fr;
#pragma unroll
  for (int m = 0; m < 4; ++m) {
    const f32x4 lo = acc[m][0], hi = acc[m][1];
    *(uint4*)((bfraw*)p.F + (size_t)(row0 + m * 16) * D + tn * 128 + nh * 64 + wc * 32 + fq * 8) =
        pack8(make_float4(lo[0], lo[1], lo[2], lo[3]), make_float4(hi[0], hi[1], hi[2], hi[3]));
  }
}

__device__ void phase_gemm_n1024(const P& p, const bfraw* A, const bfraw* WT, int K, int l, char* smem) {
  const int bid = obid();
  const int x = bid & 7, j = bid >> 3;
  const int per = gridDim.x >> 3;
  if (per != 96) {
    const int id0 = (640 * x) >> 3, id1 = (640 * (x + 1)) >> 3;
    for (int id = id0 + j; id < id1; id += per) gemm_tile<EPI_F32, 0>(p, A, WT, K, (id >> 6) * 8 + (id & 7), (id & 63) >> 3, l, smem);
    return;
  }
  const int id0 = 80 * x;
  if (j < 64) {
    const int id = id0 + j;
    gemm_tile<EPI_F32, 0>(p, A, WT, K, (id >> 6) * 8 + (id & 7), (id & 63) >> 3, l, smem);
  } else {
    const int id = id0 + 64 + ((j - 64) >> 1);
    gemm_tile_half(p, A, WT, K, (id >> 6) * 8 + (id & 7), (id & 63) >> 3, (j - 64) & 1, smem);
  }
}

template <int EPI, int MODE = 0>
__device__ void phase_gemm(const P& p, const bfraw* A, const bfraw* WT, int K, int tiles_n, int l, char* smem) {
  const int bid = obid();
  const int x = bid & 7, j = bid >> 3;
  const int per = gridDim.x >> 3;
  const int ntiles = 80 * tiles_n;
  const int id0 = (ntiles * x) >> 3, id1 = (ntiles * (x + 1)) >> 3;
  const int group_sz = 8 * tiles_n;
  for (int id = id0 + j; id < id1; id += per) {
    const int g = id / group_sz, r = id - g * group_sz;
    gemm_tile<EPI, MODE>(p, A, WT, K, g * 8 + (r & 7), r >> 3, l, smem);
  }
}

__device__ void phase_prep(const P& p, int l) {
  constexpr int NT = 4;
  const int lane = otid() & 63;
  const int gw = (obid() * 256 + otid()) >> 6, nw = gridDim.x * 4;
  const int c = lane * 4;
  const float4 kkw = *(const float4*)(p.k_k + l * 256 + c);
  const float4 kaw = *(const float4*)(p.k_a + l * 256 + c);
  for (int tok0 = gw * NT; tok0 < NTOK; tok0 += nw * NT) {
    float4 k4[NT], kk[NT];
    float tw[NT], al[NT];
#pragma unroll
    for (int t = 0; t < NT; ++t) {
      const float* z = p.Z + (size_t)(tok0 + t) * DIN;
      k4[t] = *(const float4*)(z + 2304 + c);
      kk[t] = make_float4(k4[t].x * kkw.x, k4[t].y * kkw.y, k4[t].z * kkw.z, k4[t].w * kkw.w);
      float ss = kk[t].x * kk[t].x + kk[t].y * kk[t].y + kk[t].z * kk[t].z + kk[t].w * kk[t].w;
      ss = sum16(ss);
      const float inv = rsqrtf(ss + EPS);
      kk[t].x *= inv; kk[t].y *= inv; kk[t].z *= inv; kk[t].w *= inv;
      tw[t] = tanhf(z[2816 + lane]);
      al[t] = z[2880 + lane];
      *(float4*)(p.PREP + (size_t)(tok0 + t) * NPREP + c) = kk[t];
    }
#pragma unroll
    for (int dir = 0; dir < 2; ++dir) {
      const float4 w0v = *(const float4*)(p.w0 + (l * 2 + dir) * 256 + c);
      const float4 a0v = *(const float4*)(p.a0 + (l * 2 + dir) * 256 + c);
      float4 wa[NT], aa[NT];
#pragma unroll
      for (int t = 0; t < NT; ++t) { wa[t] = w0v; aa[t] = a0v; }
      const float* w2p = p.w2 + (size_t)(l * 2 + dir) * 32 * 256 + c;
      const float* a2p = p.a2 + (size_t)(l * 2 + dir) * 32 * 256 + c;
#pragma unroll 2
      for (int r = 0; r < 32; ++r) {
        const float4 w2v = *(const float4*)(w2p + r * 256);
        const float4 a2v = *(const float4*)(a2p + r * 256);
#pragma unroll
        for (int t = 0; t < NT; ++t) {
          const float tv = bcast(tw[t], dir * 32 + r), av = bcast(al[t], dir * 32 + r);
          wa[t].x += tv * w2v.x; wa[t].y += tv * w2v.y; wa[t].z += tv * w2v.z; wa[t].w += tv * w2v.w;
          aa[t].x += av * a2v.x; aa[t].y += av * a2v.y; aa[t].z += av * a2v.z; aa[t].w += av * a2v.w;
        }
      }
      const float ce = -0.6065306597126334f;
#pragma unroll
      for (int t = 0; t < NT; ++t) {
        float* pr = p.PREP + (size_t)(tok0 + t) * NPREP;
        float4 dec = make_float4(__expf(ce * sigmoidf_(wa[t].x)), __expf(ce * sigmoidf_(wa[t].y)),
                                 __expf(ce * sigmoidf_(wa[t].z)), __expf(ce * sigmoidf_(wa[t].w)));
        float4 a = make_float4(sigmoidf_(aa[t].x), sigmoidf_(aa[t].y), sigmoidf_(aa[t].z), sigmoidf_(aa[t].w));
        *(float4*)(pr + (1 + 2 * dir) * 256 + c) = dec;
        *(float4*)(pr + (2 + 2 * dir) * 256 + c) = a;
      }
    }
  }
}

__device__ void scan_item(const P& p, int l, int item, char* smem) {
  const int tid = otid(), lane = tid & 63, wid = tid >> 6;
  const bool lat = item < 64;
  const int j = lat ? item : item - 64;
  const int quarter = j & 3, dir = (j >> 2) & 1, h = (j >> 3) & 3, b = j >> 5;
  const int T = lat ? 1024 : 256;
  const int base = lat ? NCTX + b * 1024 : b * 256;
  const int kq = lane & 15, v = quarter * 16 + wid * 4 + (lane >> 4);
  float* buf = (float*)smem;
  f32x2 S01 = {0.f, 0.f}, S23 = {0.f, 0.f};
  if (lat) {
    const float* sp = p.state + ((((size_t)(b * 2 + l) * 2 + dir) * 4 + h) * 64 + v) * 64 + kq * 4;
    const float4 s0 = *(const float4*)sp;
    S01.x = s0.x; S01.y = s0.y; S23.x = s0.z; S23.y = s0.w;
  }
  const int nch = T >> 4;
  const int lst = tid >> 4, lc4 = tid & 15;
  const int lcol = h * 64 + lc4 * 4;
  const float4 ka4 = *(const float4*)(p.k_a + l * 256 + lcol);
  float4 x0, x1, x2, x3, x4, x5, y0, y1, y2, y3, y4, y5;
#define SLOAD(G, cb)                                                                                \
  {                                                                                                 \
    const int tl_ = (cb) + lst;                                                                     \
    const int tok_ = base + (dir ? T - 1 - tl_ : tl_);                                              \
    const float* zr_ = p.Z + (size_t)tok_ * DIN + lcol;                                             \
    const float* pr_ = p.PREP + (size_t)tok_ * NPREP + lcol;                                        \
    G##0 = *(const float4*)(zr_ + 2048);                                                            \
    G##1 = *(const float4*)(pr_ + (1 + 2 * dir) * 256);                                             \
    G##2 = *(const float4*)(zr_ + 2304);                                                            \
    G##3 = *(const float4*)(pr_);                                                                   \
    G##4 = *(const float4*)(pr_ + (2 + 2 * dir) * 256);                                             \
    G##5 = *(const float4*)(zr_ + 2560);                                                            \
  }
#define SSTORE(G, dst)                                                                              \
  {                                                                                                 \
    float* d_ = (dst) + lst * 384 + lc4 * 4;                                                        \
    const float4 k_ = G##2, n_ = G##3, s_ = G##4;                                                   \
    *(float4*)(d_) = G##0; *(float4*)(d_ + 64) = G##1;                                              \
    *(float4*)(d_ + 128) = make_float4(k_.x * (1.f + (s_.x - 1.f) * ka4.x), k_.y * (1.f + (s_.y - 1.f) * ka4.y), \
                                       k_.z * (1.f + (s_.z - 1.f) * ka4.z), k_.w * (1.f + (s_.w - 1.f) * ka4.w)); \
    *(float4*)(d_ + 192) = make_float4(-n_.x, -n_.y, -n_.z, -n_.w);                                 \
    *(float4*)(d_ + 256) = make_float4(n_.x * s_.x, n_.y * s_.y, n_.z * s_.z, n_.w * s_.w);         \
    *(float4*)(d_ + 320) = G##5;                                                                    \
  }
  __syncthreads();
  SLOAD(x, 0)
  SSTORE(x, buf)
  __syncthreads();
  SLOAD(x, 16)
  SLOAD(y, 32)
  float* yb = p.Y + (size_t)dir * NTOK * 256 + h * 64 + v;
  const int kq4 = kq * 4;
  float ykeep = 0.f;
#define SI_LOAD(P_, bs_)                                                                               \
  P_##r = *(const f32x4*)((bs_) + kq4); P_##w = *(const f32x4*)((bs_) + 64 + kq4);                     \
  P_##k = *(const f32x4*)((bs_) + 128 + kq4); P_##a = *(const f32x4*)((bs_) + 192 + kq4);              \
  P_##b = *(const f32x4*)((bs_) + 256 + kq4); P_##vv = (bs_)[320 + v];
#define SI_DECL(P_) f32x4 P_##r, P_##w, P_##k, P_##a, P_##b; float P_##vv;
#define LO2(x) __builtin_shufflevector(x, x, 0, 1)
#define HI2(x) __builtin_shufflevector(x, x, 2, 3)
#define SI_STEP(P_, st_)                                                                               \
  {                                                                                                    \
    f32x2 t1 = S01 * LO2(P_##a); t1 = S23 * HI2(P_##a) + t1;                                           \
    const float sa = sum16(t1.x + t1.y);                                                               \
    const f32x2 sa2 = {sa, sa}, vv2 = {P_##vv, P_##vv};                                                \
    S01 = S01 * LO2(P_##w) + (sa2 * LO2(P_##b) + vv2 * LO2(P_##k));                                    \
    S23 = S23 * HI2(P_##w) + (sa2 * HI2(P_##b) + vv2 * HI2(P_##k));                                    \
    f32x2 u1 = S01 * LO2(P_##r); u1 = S23 * HI2(P_##r) + u1;                                           \
    const float y = sum16(u1.x + u1.y);                                                                \
    ykeep = (kq == (st_)) ? y : ykeep;                                                                 \
  }
  SI_DECL(e_) SI_DECL(o_) SI_DECL(t_)
  __builtin_amdgcn_s_setprio(3);
#define CHUNK_STEPS(cb_, ch_)                                                                          \
  {                                                                                                    \
    SI_LOAD(e_, cb_)                                                                                   \
    SI_LOAD(o_, (cb_) + 384)                                                                           \
    SI_LOAD(t_, (cb_) + 2 * 384)                                                                   \
    SI_STEP(e_, 0)                                                                                    \
    SI_LOAD(e_, (cb_) + 3 * 384)                                                                   \
    SI_STEP(o_, 1)                                                                                    \
    SI_LOAD(o_, (cb_) + 4 * 384)                                                                   \
    SI_STEP(t_, 2)                                                                                    \
    SI_LOAD(t_, (cb_) + 5 * 384)                                                                   \
    SI_STEP(e_, 3)                                                                                    \
    SI_LOAD(e_, (cb_) + 6 * 384)                                                                   \
    SI_STEP(o_, 4)                                                                                    \
    SI_LOAD(o_, (cb_) + 7 * 384)                                                                   \
    SI_STEP(t_, 5)                                                                                    \
    SI_LOAD(t_, (cb_) + 8 * 384)                                                                   \
    SI_STEP(e_, 6)                                                                                    \
    SI_LOAD(e_, (cb_) + 9 * 384)                                                                   \
    SI_STEP(o_, 7)                                                                                    \
    SI_LOAD(o_, (cb_) + 10 * 384)                                                                   \
    SI_STEP(t_, 8)                                                                                    \
    SI_LOAD(t_, (cb_) + 11 * 384)                                                                   \
    SI_STEP(e_, 9)                                                                                    \
    SI_LOAD(e_, (cb_) + 12 * 384)                                                                   \
    SI_STEP(o_, 10)                                                                                    \
    SI_LOAD(o_, (cb_) + 13 * 384)                                                                   \
    SI_STEP(t_, 11)                                                                                    \
    SI_LOAD(t_, (cb_) + 14 * 384)                                                                   \
    SI_STEP(e_, 12)                                                                                    \
    SI_LOAD(e_, (cb_) + 15 * 384)                                                                   \
    SI_STEP(o_, 13)                                                                                    \
    SI_STEP(t_, 14)                                                                                    \
    SI_STEP(e_, 15)                                                                                    \
    const int tl = (ch_) * 16 + kq;                                                                    \
    const int tok = base + (dir ? T - 1 - tl : tl);                                                    \
    yb[(size_t)tok * 256] = ykeep;                                                                     \
  }
  float* buf1 = buf + 16 * 384;
  for (int ch = 0; ch < nch; ch += 2) {
    CHUNK_STEPS(buf, ch)
    SSTORE(x, buf1)
    __syncthreads();
    if (ch + 3 < nch) { SLOAD(x, (ch + 3) * 16) }
    CHUNK_STEPS(buf1, ch + 1)
    if (ch + 2 < nch) { SSTORE(y, buf) }
    __syncthreads();
    if (ch + 4 < nch) { SLOAD(y, (ch + 4) * 16) }
  }
#undef CHUNK_STEPS
  __builtin_amdgcn_s_setprio(0);
#undef SI_LOAD
#undef SI_DECL
#undef SI_STEP
#undef LO2
#undef HI2
#undef SLOAD
#undef SSTORE
  if (!lat) {
    float* dp = p.out_state + ((((size_t)(b * 2 + l) * 2 + dir) * 4 + h) * 64 + v) * 64 + kq * 4;
    *(float4*)dp = make_float4(S01.x, S01.y, S23.x, S23.y);
  }
}

__device__ void scan_item8(const P& p, int l, int item, char* smem) {
  const int tid = otid(), lane = tid & 63, wid = tid >> 6;
  const bool lat = false;
  const int j = item;
  const int half = j & 1, dir = (j >> 1) & 1, h = (j >> 2) & 3, b = j >> 4;
  const int T = lat ? 1024 : 256;
  const int base = lat ? NCTX + b * 1024 : b * 256;
  const int kq = lane & 7, v = half * 32 + wid * 8 + (lane >> 3);
  float* buf = (float*)smem;
  float S[8];
  if (lat) {
    const float* sp = p.state + ((((size_t)(b * 2 + l) * 2 + dir) * 4 + h) * 64 + v) * 64 + kq * 8;
    float4 s0 = *(const float4*)sp, s1 = *(const float4*)(sp + 4);
    S[0] = s0.x; S[1] = s0.y; S[2] = s0.z; S[3] = s0.w; S[4] = s1.x; S[5] = s1.y; S[6] = s1.z; S[7] = s1.w;
  } else {
#pragma unroll
    for (int i = 0; i < 8; ++i) S[i] = 0.f;
  }
  const int nch = T >> 4;
  const int lst = tid >> 4, lc4 = tid & 15;
  const int lcol = h * 64 + lc4 * 4;
  const float4 ka4 = *(const float4*)(p.k_a + l * 256 + lcol);
  float4 g0, g1, g2, g3, g4, g5;
#define SLOAD(cb)                                                                                   \
  {                                                                                                 \
    const int tl_ = (cb) + lst;                                                                     \
    const int tok_ = base + (dir ? T - 1 - tl_ : tl_);                                              \
    const float* zr_ = p.Z + (size_t)tok_ * DIN + lcol;                                             \
    const float* pr_ = p.PREP + (size_t)tok_ * NPREP + lcol;                                        \
    g0 = *(const float4*)(zr_ + 2048);                                                              \
    g1 = *(const float4*)(pr_ + (1 + 2 * dir) * 256);                                               \
    g2 = *(const float4*)(zr_ + 2304);                                                              \
    g3 = *(const float4*)(pr_);                                                                     \
    g4 = *(const float4*)(pr_ + (2 + 2 * dir) * 256);                                               \
    g5 = *(const float4*)(zr_ + 2560);                                                              \
  }
#define SSTORE(dst)                                                                                 \
  {                                                                                                 \
    float* d_ = (dst) + lst * 384 + lc4 * 4;                                                        \
    *(float4*)(d_) = g0; *(float4*)(d_ + 64) = g1;                                                  \
    *(float4*)(d_ + 128) = make_float4(g2.x * (1.f + (g4.x - 1.f) * ka4.x), g2.y * (1.f + (g4.y - 1.f) * ka4.y), \
                                       g2.z * (1.f + (g4.z - 1.f) * ka4.z), g2.w * (1.f + (g4.w - 1.f) * ka4.w)); \
    *(float4*)(d_ + 192) = make_float4(-g3.x, -g3.y, -g3.z, -g3.w);                                 \
    *(float4*)(d_ + 256) = make_float4(g3.x * g4.x, g3.y * g4.y, g3.z * g4.z, g3.w * g4.w);         \
    *(float4*)(d_ + 320) = g5;                                                                      \
  }
  __syncthreads();
  SLOAD(0)
  SSTORE(buf)
  __syncthreads();
  float* yb = p.Y + (size_t)dir * NTOK * 256 + h * 64 + v;
  const int kq8 = kq * 8;
  float ykeep = 0.f;
#define SI_LOAD(P_, bs_)                                                                               \
  P_##r0 = *(const f32x4*)((bs_) + kq8); P_##r1 = *(const f32x4*)((bs_) + kq8 + 4);                    \
  P_##w0 = *(const f32x4*)((bs_) + 64 + kq8); P_##w1 = *(const f32x4*)((bs_) + 64 + kq8 + 4);          \
  P_##k0 = *(const f32x4*)((bs_) + 128 + kq8); P_##k1 = *(const f32x4*)((bs_) + 128 + kq8 + 4);        \
  P_##a0 = *(const f32x4*)((bs_) + 192 + kq8); P_##a1 = *(const f32x4*)((bs_) + 192 + kq8 + 4);        \
  P_##b0 = *(const f32x4*)((bs_) + 256 + kq8); P_##b1 = *(const f32x4*)((bs_) + 256 + kq8 + 4);        \
  P_##vv = (bs_)[320 + v];
#define SI_DECL(P_) f32x4 P_##r0, P_##r1, P_##w0, P_##w1, P_##k0, P_##k1, P_##a0, P_##a1, P_##b0, P_##b1; float P_##vv;
#define LO2(x) __builtin_shufflevector(x, x, 0, 1)
#define HI2(x) __builtin_shufflevector(x, x, 2, 3)
#define SI_STEP(P_, st_)                                                                               \
  {                                                                                                    \
    f32x2 t1 = S01 * LO2(P_##a0); t1 = S23 * HI2(P_##a0) + t1;                                         \
    f32x2 t2 = S45 * LO2(P_##a1); t2 = S67 * HI2(P_##a1) + t2;                                         \
    t1 = t1 + t2;                                                                                      \
    float sa = sum8(t1.x + t1.y);                                                                      \
    const f32x2 sa2 = {sa, sa}, vv2 = {P_##vv, P_##vv};                                                \
    S01 = S01 * LO2(P_##w0) + (sa2 * LO2(P_##b0) + vv2 * LO2(P_##k0));                                 \
    S23 = S23 * HI2(P_##w0) + (sa2 * HI2(P_##b0) + vv2 * HI2(P_##k0));                                 \
    S45 = S45 * LO2(P_##w1) + (sa2 * LO2(P_##b1) + vv2 * LO2(P_##k1));                                 \
    S67 = S67 * HI2(P_##w1) + (sa2 * HI2(P_##b1) + vv2 * HI2(P_##k1));                                 \
    f32x2 u1 = S01 * LO2(P_##r0); u1 = S23 * HI2(P_##r0) + u1;                                         \
    f32x2 u2 = S45 * LO2(P_##r1); u2 = S67 * HI2(P_##r1) + u2;                                         \
    u1 = u1 + u2;                                                                                      \
    const float y = sum8(u1.x + u1.y);                                                                 \
    ykeep = (kq == ((st_)&7)) ? y : ykeep;                                                             \
    if (((st_)&7) == 7) {                                                                              \
      const int tl = ch * 16 + ((st_)&8) + kq;                                                         \
      const int tok = base + (dir ? T - 1 - tl : tl);                                                  \
      yb[(size_t)tok * 256] = ykeep;                                                                   \
    }                                                                                                  \
  }
  f32x2 S01 = {S[0], S[1]}, S23 = {S[2], S[3]}, S45 = {S[4], S[5]}, S67 = {S[6], S[7]};
  SI_DECL(e_) SI_DECL(o_)
  __builtin_amdgcn_s_setprio(2);
  for (int ch = 0; ch < nch; ++ch) {
    const int cur = ch & 1;
    if (ch + 1 < nch) { SLOAD((ch + 1) * 16) }
    const float* cb = buf + cur * (16 * 384);
    SI_LOAD(e_, cb)
#pragma unroll 1
    for (int st = 0; st < 16; st += 2) {
      SI_LOAD(o_, cb + (st + 1) * 384)
      SI_STEP(e_, st)
      if (st + 2 < 16) { SI_LOAD(e_, cb + (st + 2) * 384) }
      SI_STEP(o_, st + 1)
    }
    if (ch + 1 < nch) {
      float* nb = buf + (cur ^ 1) * (16 * 384);
      SSTORE(nb)
    }
    __syncthreads();
  }
  __builtin_amdgcn_s_setprio(0);
#undef SI_LOAD
#undef SI_DECL
#undef SI_STEP
#undef LO2
#undef HI2
  S[0] = S01.x; S[1] = S01.y; S[2] = S23.x; S[3] = S23.y; S[4] = S45.x; S[5] = S45.y; S[6] = S67.x; S[7] = S67.y;
#undef SLOAD
#undef SSTORE
  if (!lat) {
    float* dp = p.out_state + ((((size_t)(b * 2 + l) * 2 + dir) * 4 + h) * 64 + v) * 64 + kq * 8;
    *(float4*)dp = make_float4(S[0], S[1], S[2], S[3]);
    *(float4*)(dp + 4) = make_float4(S[4], S[5], S[6], S[7]);
  }
}

__device__ void attn_unit(const P& p, int l, int unit, char* smem) {
  const int tid = otid(), lane = tid & 63, wid = tid >> 6;
  const int fr = lane & 15, fq = lane >> 4;
  char* sK = smem;
  bfraw* sVt = (bfraw*)(smem + 16384);
  bfraw* sP = (bfraw*)(smem + 16384 + 17408);
  float* sRpb = (float*)(smem + 16384 + 2 * 17408);
  const bool na = unit >= 1024;
  int b, h, qtok0, r = 0, rs = 0;
  __syncthreads();
  if (!na) { const int qb = unit & 3; h = (unit >> 2) & 7; b = unit >> 5; qtok0 = b * 256 + qb * 64; }
  else {
    const int u = unit - 1024; r = u & 15; h = (u >> 4) & 7; b = u >> 7;
    qtok0 = NCTX + b * 1024 + r * 64; rs = min(max(r - 4, 0), 8);
    for (int i = tid; i < 465; i += 256) sRpb[i] = p.rpb[(size_t)(l * 8 + h) * 465 + i];
  }
  bf16x8 qf[2];
  {
    const bfraw* qp = p.QB + (size_t)(qtok0 + wid * 16 + fr) * 512 + h * 64 + fq * 8;
#pragma unroll
    for (int s = 0; s < 2; ++s) qf[s] = as_bf8(*(const uint4*)(qp + s * 32));
  }
  float m_run[4], l_run[4];
  f32x4 o[4];
#pragma unroll
  for (int j = 0; j < 4; ++j) { m_run[j] = -1e30f; l_run[j] = 0.f; o[j] = (f32x4){0.f, 0.f, 0.f, 0.f}; }
  const int nseg = na ? 6 : 2;
  const int sw = (fr >> 1) & 7;
  for (int seg = 0; seg < nseg; ++seg) {
    const float *kbase, *vbase;
    int kstride, krow0 = 0;
    bool local = false;
    if (!na) {
      const size_t i0 = ((size_t)(b * 2 + l) * 256 + seg * 128) * 512 + h * 64;
      kbase = p.out_k + i0; vbase = p.out_v + i0; kstride = 512;
    } else if (seg < 2) {
      const size_t i0 = ((size_t)(b * 2 + l) * 256 + seg * 128) * 512 + h * 64;
      kbase = p.cache_k + i0; vbase = p.cache_v + i0; kstride = 512;
    } else {
      krow0 = rs + 2 * (seg - 2);
      const size_t t0 = (size_t)(NCTX + b * 1024 + krow0 * 64) * DIN + h * 64;
      kbase = p.Z + t0 + 512; vbase = p.Z + t0 + 1024; kstride = DIN; local = true;
    }
    __syncthreads();
    {
      const int key = tid >> 1, hf = tid & 1;
      const float* kp = kbase + (size_t)key * kstride + hf * 32;
      const float* vp = vbase + (size_t)key * kstride + hf * 32;
#pragma unroll
      for (int c = 0; c < 4; ++c) {
        float4 x0 = *(const float4*)(kp + c * 8), x1 = *(const float4*)(kp + c * 8 + 4);
        const int chunk = hf * 4 + c;
        *(uint4*)(sK + key * 128 + ((chunk ^ ((key >> 1) & 7)) << 4)) = pack8(x0, x1);
      }
#pragma unroll
      for (int c = 0; c < 8; ++c) {
        float4 x = *(const float4*)(vp + c * 4);
        bfraw* d = sVt + (hf * 8 + c) * 136 + key;
        d[0] = (bfraw)f2bf(x.x); d[16 * 136] = (bfraw)f2bf(x.y); d[32 * 136] = (bfraw)f2bf(x.z); d[48 * 136] = (bfraw)f2bf(x.w);
      }
    }
    __syncthreads();
    f32x4 s[8];
#pragma unroll
    for (int n = 0; n < 8; ++n) {
      f32x4 acc = (f32x4){0.f, 0.f, 0.f, 0.f};
#pragma unroll
      for (int ks = 0; ks < 2; ++ks) {
        bf16x8 kf = *(const bf16x8*)(sK + (n * 16 + fr) * 128 + (((ks * 4 + fq) ^ sw) << 4));
        acc = mfma16(qf[ks], kf, acc);
      }
      s[n] = acc;
    }
#pragma unroll
    for (int n = 0; n < 8; ++n)
#pragma unroll
      for (int j = 0; j < 4; ++j) {
        float v = s[n][j] * 0.125f;
        if (local) {
          const int qc = wid * 16 + fq * 4 + j;
          const int kidx = n * 16 + fr;
          const int krow = krow0 + (kidx >> 6), kc = kidx & 63;
          const int cs = min(max(qc - 8, 0), 48);
          const bool ok = (kc >= cs) && (kc < cs + 16);
          const int dr = krow - r + 7;
          const int dc = min(max(kc - qc + 15, 0), 30);
          const float bias = sRpb[dr * 31 + dc];
          v = ok ? v + bias : -1e30f;
        }
        s[n][j] = v;
      }
#pragma unroll
    for (int j = 0; j < 4; ++j) {
      float mx = s[0][j];
#pragma unroll
      for (int n = 1; n < 8; ++n) mx = fmaxf(mx, s[n][j]);
      mx = max16(mx);
      const float mn = fmaxf(m_run[j], mx);
      const float alpha = __expf(m_run[j] - mn);
      float sum = 0.f;
#pragma unroll
      for (int n = 0; n < 8; ++n) { float pv = __expf(s[n][j] - mn); s[n][j] = pv; sum += pv; }
      sum = sum16(sum);
      l_run[j] = l_run[j] * alpha + sum;
      m_run[j] = mn;
#pragma unroll
      for (int n = 0; n < 4; ++n) o[n][j] *= alpha;
    }
#pragma unroll
    for (int n = 0; n < 8; ++n)
#pragma unroll
      for (int j = 0; j < 4; ++j) sP[(wid * 16 + fq * 4 + j) * 136 + n * 16 + fr] = (bfraw)f2bf(s[n][j]);
    __syncthreads();
#pragma unroll
    for (int ks = 0; ks < 4; ++ks) {
      bf16x8 pf = *(const bf16x8*)(sP + (wid * 16 + fr) * 136 + ks * 32 + fq * 8);
#pragma unroll
      for (int n = 0; n < 4; ++n) {
        bf16x8 vf = *(const bf16x8*)(sVt + (n * 16 + fr) * 136 + ks * 32 + fq * 8);
        o[n] = mfma16(pf, vf, o[n]);
      }
    }
  }
#pragma unroll
  for (int j = 0; j < 4; ++j) {
    const float inv = 1.f / l_run[j];
    uint2 ov; ov.x = pack2(o[0][j] * inv, o[1][j] * inv); ov.y = pack2(o[2][j] * inv, o[3][j] * inv);
    *(uint2*)(p.O + (size_t)(qtok0 + wid * 16 + fq * 4 + j) * D + h * 64 + 4 * fr) = ov;
  }
}

__device__ void sgu_unit(const P& p, int l, int unit, char* smem) {
  const int tid = otid(), lane = tid & 63, wid = tid >> 6;
  const int fr = lane & 15, fq = lane >> 4;
  const int g = unit & 3, chunk = unit >> 2;
  const int tok0 = chunk * 128;
  char* sA = smem;
  bfraw* sVn = (bfraw*)(smem + 32768);
  float* sStat = (float*)(smem + 32768 + 17408);
  __syncthreads();
  {
    const int q = tid >> 1, hf = tid & 1;
    const uint4* vp = (const uint4*)(p.UB + (size_t)(tok0 + q) * 512 + 256 + hf * 128);
    float s1 = 0.f, s2 = 0.f;
#pragma unroll 8
    for (int i = 0; i < 16; ++i) {
      float4 xa, xb2;
      unpack8(vp[i], xa, xb2);
      s1 += ((xa.x + xa.y) + (xa.z + xa.w)) + ((xb2.x + xb2.y) + (xb2.z + xb2.w));
      s2 += ((xa.x * xa.x + xa.y * xa.y) + (xa.z * xa.z + xa.w * xa.w)) + ((xb2.x * xb2.x + xb2.y * xb2.y) + (xb2.z * xb2.z + xb2.w * xb2.w));
    }
    s1 += dpp<0xB1>(s1); s2 += dpp<0xB1>(s2);
    const float mu = s1 * (1.f / 256.f);
    const float var = fmaxf(s2 * (1.f / 256.f) - mu * mu, 0.f);
    const float rstd = rsqrtf(var + EPS);
    const uint4* gp = (const uint4*)(p.UB + (size_t)(tok0 + q) * 512 + 256 + g * 64 + hf * 32);
    const float* lw = p.sgu_ln_w + l * 256 + g * 64 + hf * 32;
    const float* lb = p.sgu_ln_b + l * 256 + g * 64 + hf * 32;
#pragma unroll
    for (int c = 0; c < 4; ++c) {
      float4 x0, x1;
      unpack8(gp[c], x0, x1);
#pragma unroll
      for (int e2 = 0; e2 < 2; ++e2) {
        const float4 x = e2 ? x1 : x0;
        const float4 w = *(const float4*)(lw + c * 8 + e2 * 4), bb = *(const float4*)(lb + c * 8 + e2 * 4);
        bfraw* d = sVn + (hf * 8 + c * 2 + e2) * 136 + q;
        d[0] = (bfraw)f2bf((x.x - mu) * rstd * w.x + bb.x);
        d[16 * 136] = (bfraw)f2bf((x.y - mu) * rstd * w.y + bb.y);
        d[32 * 136] = (bfraw)f2bf((x.z - mu) * rstd * w.z + bb.z);
        d[48 * 136] = (bfraw)f2bf((x.w - mu) * rstd * w.w + bb.w);
      }
    }
    const float* wsrc = p.sgu_w_s + (size_t)(l * 4 + g) * 128 * 128;
    const int prow = tid >> 1;
#pragma unroll
    for (int c = 0; c < 8; ++c) {
      const int chunkc = hf * 8 + c;
      float4 x0 = *(const float4*)(wsrc + prow * 128 + chunkc * 8), x1 = *(const float4*)(wsrc + prow * 128 + chunkc * 8 + 4);
      *(uint4*)(sA + prow * 256 + ((chunkc ^ (prow & 15)) << 4)) = pack8(x0, x1);
    }
    (void)sStat;
  }
  __syncthreads();
  f32x4 acc[2][4];
#pragma unroll
  for (int m = 0; m < 2; ++m)
#pragma unroll
    for (int n = 0; n < 4; ++n) acc[m][n] = (f32x4){0.f, 0.f, 0.f, 0.f};
#pragma unroll
  for (int ks = 0; ks < 4; ++ks) {
    bf16x8 af[2], bf[4];
#pragma unroll
    for (int m = 0; m < 2; ++m) {
      const int row = wid * 32 + m * 16 + fr;
      af[m] = *(const bf16x8*)(sA + row * 256 + (((ks * 4 + fq) ^ (row & 15)) << 4));
    }
#pragma unroll
    for (int n = 0; n < 4; ++n) bf[n] = *(const bf16x8*)(sVn + (n * 16 + fr) * 136 + ks * 32 + fq * 8);
#pragma unroll
    for (int m = 0; m < 2; ++m)
#pragma unroll
      for (int n = 0; n < 4; ++n) acc[m][n] = mfma16(af[m], bf[n], acc[m][n]);
  }
#pragma unroll
  for (int m = 0; m < 2; ++m)
#pragma unroll
    for (int j = 0; j < 4; ++j) {
      const int pr = wid * 32 + m * 16 + fq * 4 + j;
      const float bs = p.sgu_b_s[(l * 4 + g) * 128 + pr];
      const uint2 ub = *(const uint2*)(p.UB + (size_t)(tok0 + pr) * 512 + g * 64 + 4 * fr);
      const float4 u = make_float4(__uint_as_float(ub.x << 16), __uint_as_float(ub.x & 0xffff0000u), __uint_as_float(ub.y << 16),
                                   __uint_as_float(ub.y & 0xffff0000u));
      uint2 ov; ov.x = pack2(u.x * (acc[m][0][j] + bs), u.y * (acc[m][1][j] + bs));
      ov.y = pack2(u.z * (acc[m][2][j] + bs), u.w * (acc[m][3][j] + bs));
      *(uint2*)(p.O + (size_t)(tok0 + pr) * D + 512 + g * 64 + 4 * fr) = ov;
    }
}

__device__ void phase_mixer(const P& p, int l, char* smem, int* s_item, int rep) {
  const int nitems = 576 + 256 + 1024 + 320 + ((l == 0 && rep == 0) ? N_LATE_T : 0);
  unsigned* ctr = p.bar + XCD_BAR_WORDS + 16 * l + 4 * rep;
  for (;;) {
    __syncthreads();
    if (otid() == 0) *s_item = (int)atomicAdd(ctr, 1u);
    __syncthreads();
    const int i = *s_item;
    if (i >= nitems) break;
    if (i < 64) scan_item(p, l, i, smem);
    else if (i < 576) scan_item8(p, l, i - 64, smem);
    else if (i < 832) attn_unit(p, l, 1024 + (i - 576), smem);
    else if (i < 1856) attn_unit(p, l, i - 832, smem);
    else if (i < 2176) sgu_unit(p, l, i - 1856, smem);
    else transpose_item(p, late_transpose_id(i - 2176), smem);
  }
}

__device__ void phase_post(const P& p, int l) {
  constexpr int NT = 4;
  const int lane = otid() & 63;
  const int gw = (obid() * 256 + otid()) >> 6, nw = gridDim.x * 4;
  const int c = lane * 4;
  const float4 lnw = *(const float4*)(p.ln_w + l * 256 + c);
  const float4 lnb = *(const float4*)(p.ln_b + l * 256 + c);
  const float4 rkw = *(const float4*)(p.r_k + l * 256 + c);
  const float* g2p = p.g2 + (size_t)l * 64 * 256 + c;
  for (int tok0 = gw * NT; tok0 < NTOK; tok0 += nw * NT) {
    float sg[NT];
    float4 g[NT];
#pragma unroll
    for (int t = 0; t < NT; ++t) {
      sg[t] = sigmoidf_(p.Z[(size_t)(tok0 + t) * DIN + 2944 + lane]);
      g[t] = make_float4(0.f, 0.f, 0.f, 0.f);
    }
#pragma unroll 4
    for (int r = 0; r < 64; ++r) {
      const float4 w = *(const float4*)(g2p + r * 256);
#pragma unroll
      for (int t = 0; t < NT; ++t) {
        const float sv = bcast(sg[t], r);
        g[t].x += sv * w.x; g[t].y += sv * w.y; g[t].z += sv * w.z; g[t].w += sv * w.w;
      }
    }
#pragma unroll
    for (int t = 0; t < NT; ++t) {
      const int tok = tok0 + t;
      const float* z = p.Z + (size_t)tok * DIN;
      const float4 yf = *(const float4*)(p.Y + (size_t)tok * 256 + c);
      const float4 yb = *(const float4*)(p.Y + (size_t)(NTOK + tok) * 256 + c);
      float4 y = make_float4(yf.x + yb.x, yf.y + yb.y, yf.z + yb.z, yf.w + yb.w);
      const float s1 = sum16((y.x + y.y) + (y.z + y.w));
      const float mu = s1 * (1.f / 64.f);
      y.x -= mu; y.y -= mu; y.z -= mu; y.w -= mu;
      const float s2 = sum16((y.x * y.x + y.y * y.y) + (y.z * y.z + y.w * y.w));
      const float rstd = rsqrtf(s2 * (1.f / 64.f) + GN_EPS);
      const float4 r4 = *(const float4*)(z + 2048 + c);
      const float4 k4 = *(const float4*)(z + 2304 + c);
      const float4 v4 = *(const float4*)(z + 2560 + c);
      const float rk = sum16((r4.x * k4.x * rkw.x + r4.y * k4.y * rkw.y) + (r4.z * k4.z * rkw.z + r4.w * k4.w * rkw.w));
      const float o0 = (y.x * rstd * lnw.x + lnb.x + rk * v4.x) * g[t].x;
      const float o1 = (y.y * rstd * lnw.y + lnb.y + rk * v4.y) * g[t].y;
      const float o2 = (y.z * rstd * lnw.z + lnb.z + rk * v4.z) * g[t].z;
      const float o3 = (y.w * rstd * lnw.w + lnb.w + rk * v4.w) * g[t].w;
      uint2 ov; ov.x = pack2(o0, o1); ov.y = pack2(o2, o3);
      *(uint2*)(p.O + (size_t)tok * D + 768 + c) = ov;
    }
  }
}

constexpr int NPHASE = 26;

__global__ void __launch_bounds__(256, 3) mk(P p, int ph_lo, int ph_hi) {
  __shared__ __attribute__((aligned(16))) char smem[53248];
  __shared__ uint4 xb_words;
  __shared__ int s_item;
  cg::grid_group grid = cg::this_grid();
  if (ph_hi < 0) grid.sync();
  if (threadIdx.x == 0) xb_words = make_uint4(0u, 0u, 0u, 0u);
  __syncthreads();
  XcdBarrier xb;
  xb.bar = p.bar; xb.x = 0; xb.st = (volatile LAS unsigned*)&xb_words;
  if (ph_hi - ph_lo > 1) xb = xcd_barrier_post(p.bar, (volatile LAS unsigned*)&xb_words);
#define RUN(idx, ...)                                   \
  if (ph_lo <= (idx) && (idx) < ph_hi) {                \
    __VA_ARGS__;                                        \
    if ((idx) + 1 < ph_hi) xcd_barrier(xb);             \
  }
#define RUNS(slot, idx, ...)                                                  \
  if (ph_lo <= (idx) && (idx) < ph_hi) {                                      \
    const int nrep = 1 + (((REPMASK) >> (slot)) & 1);                         \
    for (int rep = 0; rep < nrep; ++rep) {                                    \
      __VA_ARGS__;                                                            \
      if (rep + 1 < nrep || (idx) + 1 < ph_hi) xcd_barrier(xb);               \
    }                                                                         \
  }
  RUN(0, phase_prologue(p, smem, &s_item))
  RUN(1, phase_rowop(p, 0, -1, 0, 0))
  for (int l = 0; l < 2; ++l) {
    const int pb = 2 + 12 * l;
    RUNS(0, pb + 0, phase_gemm<EPI_SWIGLU>(p, p.H, p.wt_gu + (size_t)(l * 2 + 0) * 5632 * 1024, 1024, 44, l, smem))
#if PROBE_MODE
    if (l == 0 && ph_hi - ph_lo > 1) { phase_gemm<EPI_SWIGLU, PROBE_MODE>(p, p.H, p.wt_gu, 1024, 44, l, smem); xcd_barrier(xb); }
#endif
    RUNS(1, pb + 1, phase_gemm_n1024(p, p.ACT, p.wt_down + (size_t)(l * 2 + 0) * 1024 * 2816, 2816, l, smem))
    RUN(pb + 2, phase_rowop(p, l, 0, l, 1))
    RUNS(3, pb + 3, phase_gemm<EPI_Z>(p, p.H, p.wt_in + (size_t)l * DINP * 1024, 1024, 24, l, smem))
    RUNS(4, pb + 4, phase_prep(p, l))
    RUNS(5, pb + 5, phase_mixer(p, l, smem, &s_item, rep))
    RUNS(6, pb + 6, phase_post(p, l))
    RUNS(7, pb + 7, phase_gemm_n1024(p, p.O, p.wt_out + (size_t)l * 1024 * 1024, 1024, l, smem))
    RUN(pb + 8, phase_rowop(p, l, 1, l, 2))
    RUNS(9, pb + 9, phase_gemm<EPI_SWIGLU>(p, p.H, p.wt_gu + (size_t)(l * 2 + 1) * 5632 * 1024, 1024, 44, l, smem))
    RUNS(10, pb + 10, phase_gemm_n1024(p, p.ACT, p.wt_down + (size_t)(l * 2 + 1) * 1024 * 2816, 2816, l, smem))
    RUN(pb + 11, phase_rowop(p, l, 2, l + 1, (l + 1 < 2) ? 0 : -1))
  }
#undef RUN
#undef RUNS
}

extern "C" void kernel_launch(void* const* d_in, const int* in_sizes, int n_in, void* d_out, int out_size, void* d_ws,
                              size_t ws_size, hipStream_t stream) {
  static int grid_blocks = 0;
  if (!grid_blocks) {
    int dev = 0, cus = 0, per_cu = 0;
    hipGetDevice(&dev);
    hipDeviceGetAttribute(&cus, hipDeviceAttributeMultiprocessorCount, dev);
    hipOccupancyMaxActiveBlocksPerMultiprocessor(&per_cu, mk, 256, 0);
    if (per_cu > 3) per_cu = 3;
    if (per_cu < 1) per_cu = 1;
    grid_blocks = cus * per_cu;
  }
  P p{};
  const float* const* in = (const float* const*)d_in;
  p.x_prompt = in[0]; p.x_sample = in[1]; p.cache_k = in[2]; p.cache_v = in[3]; p.state = in[4]; p.c = in[5];
  p.c_ctx = in[6]; p.w_ada = in[7]; p.b_ada = in[8]; p.norm_pre = in[9]; p.norm_post = in[10]; p.w_gu = in[11];
  p.w_down = in[12]; p.w_in = in[13]; p.w_out = in[14]; p.rpb = in[15]; p.sgu_ln_w = in[16]; p.sgu_ln_b = in[17];
  p.sgu_w_s = in[18]; p.sgu_b_s = in[19]; p.w0 = in[20]; p.w2 = in[21]; p.a0 = in[22]; p.a2 = in[23]; p.g2 = in[24];
  p.k_k = in[25]; p.k_a = in[26]; p.r_k = in[27]; p.ln_w = in[28]; p.ln_b = in[29];
  float* out = (float*)d_out;
  p.X = out;
  p.out_k = out + (size_t)NTOK * D;
  p.out_v = p.out_k + (size_t)32 * 2 * 256 * 512;
  p.out_state = p.out_v + (size_t)32 * 2 * 256 * 512;
  char* ws = (char*)d_ws;
  size_t off = 0;
  auto take = [&](size_t bytes) { char* r = ws + off; off += (bytes + 255) & ~(size_t)255; return r; };
  p.wt_gu = (bfraw*)take((size_t)4 * 5632 * 1024 * 2);
  p.wt_down = (bfraw*)take((size_t)4 * 1024 * 2816 * 2);
  p.wt_in = (bfraw*)take((size_t)2 * DINP * 1024 * 2);
  p.wt_out = (bfraw*)take((size_t)2 * 1024 * 1024 * 2);
  p.mods = (float*)take((size_t)2 * 3 * 9216 * 4);
  char* hy = take((size_t)NTOK * D * 2);
  p.H = (bfraw*)hy; p.Y = (float*)hy;
  char* u = take((size_t)NTOK * DIN * 4);
  p.Z = (float*)u; p.ACT = (bfraw*)u; p.F = (float*)(u + ((size_t)64 << 20));
  p.O = (bfraw*)take((size_t)NTOK * D * 2);
  p.PREP = (float*)take((size_t)NTOK * NPREP * 4);
  p.XB = (bfraw*)take((size_t)NTOK * D * 2);
  p.QB = (bfraw*)take((size_t)NTOK * 512 * 2);
  p.UB = (bfraw*)take((size_t)NTOK * 512 * 2);
  p.bar = (unsigned*)take((size_t)(XCD_BAR_WORDS + 64) * 4);
  if (off > ws_size) { fprintf(stderr, "workspace too small: need %zu have %zu\n", off, ws_size); return; }
  hipMemsetAsync(p.bar, 0, (size_t)(XCD_BAR_WORDS + 64) * 4, stream);
#if COOP
  int lo = 0, hi = NPHASE;
  void* args[] = {&p, &lo, &hi};
  hipError_t e = hipLaunchCooperativeKernel((void*)mk, dim3(grid_blocks), dim3(256), args, 0, stream);
  if (e != hipSuccess) fprintf(stderr, "cooperative launch failed: %s (grid %d)\n", hipGetErrorString(e), grid_blocks);
#else
  for (int ph = 0; ph < NPHASE; ++ph) mk<<<dim3(grid_blocks), dim3(256), 0, stream>>>(p, ph, ph + 1);
#endif
}
```

```cpp
#include <hip/hip_runtime.h>
#include <hip/hip_cooperative_groups.h>
#include <cstdio>
namespace cg = cooperative_groups;

#ifndef REPMASK
#define REPMASK 0x0
#endif
#ifndef PROBE_MODE
#define PROBE_MODE 0
#endif
#ifndef MIXREP
#define MIXREP 0
#endif
#ifndef COOP
#define COOP 1
#endif

typedef unsigned short bfraw;
typedef __attribute__((ext_vector_type(8))) short bf16x8;
typedef __attribute__((ext_vector_type(4))) float f32x4;
typedef __attribute__((ext_vector_type(2))) float f32x2;

constexpr int D = 1024, NTOK = 10240, NCTX = 8192, DFF = 2816, DIN = 3008, DINP = 3072;
constexpr int NPREP = 1280;
constexpr float EPS = 1e-6f, GN_EPS = 64e-5f;

struct P {
  const float *x_prompt, *x_sample, *cache_k, *cache_v, *state, *c, *c_ctx, *w_ada, *b_ada, *norm_pre, *norm_post,
      *w_gu, *w_down, *w_in, *w_out, *rpb, *sgu_ln_w, *sgu_ln_b, *sgu_w_s, *sgu_b_s, *w0, *w2, *a0, *a2, *g2, *k_k,
      *k_a, *r_k, *ln_w, *ln_b;
  float *X, *out_k, *out_v, *out_state;
  bfraw *wt_gu, *wt_down, *wt_in, *wt_out;
  float* mods;
  bfraw* H;
  float* Y;
  float* Z;
  bfraw* ACT;
  float* F;
  bfraw* O;
  float* PREP;
  unsigned* bar;
  bfraw* XB;
  bfraw* QB;
};

__device__ __forceinline__ int otid() { int t = threadIdx.x; asm volatile("" : "+v"(t)); return t; }
__device__ __forceinline__ int obid() { int b = blockIdx.x; asm volatile("" : "+s"(b)); return b; }
__device__ __forceinline__ unsigned f2bf(float f) {
  unsigned u = __float_as_uint(f);
  u += 0x7fffu + ((u >> 16) & 1u);
  return u >> 16;
}
__device__ __forceinline__ unsigned pack2(float a, float b) { return f2bf(a) | (f2bf(b) << 16); }
__device__ __forceinline__ uint4 pack8(float4 a, float4 b) {
  uint4 r;
  r.x = pack2(a.x, a.y); r.y = pack2(a.z, a.w); r.z = pack2(b.x, b.y); r.w = pack2(b.z, b.w);
  return r;
}
__device__ __forceinline__ float sigmoidf_(float x) { return 1.f / (1.f + __expf(-x)); }

template <int CTRL>
__device__ __forceinline__ float dpp(float x) {
  return __int_as_float(__builtin_amdgcn_update_dpp(0, __float_as_int(x), CTRL, 0xF, 0xF, true));
}
__device__ __forceinline__ float sum8(float x) {
  x += dpp<0xB1>(x); x += dpp<0x4E>(x); x += dpp<0x141>(x);
  return x;
}
__device__ __forceinline__ float sum16(float x) {
  x += dpp<0xB1>(x); x += dpp<0x4E>(x); x += dpp<0x141>(x); x += dpp<0x140>(x);
  return x;
}
__device__ __forceinline__ float max16(float x) {
  x = fmaxf(x, dpp<0xB1>(x)); x = fmaxf(x, dpp<0x4E>(x)); x = fmaxf(x, dpp<0x141>(x)); x = fmaxf(x, dpp<0x140>(x));
  return x;
}
__device__ __forceinline__ float sum64(float x) {
#pragma unroll
  for (int o = 32; o > 0; o >>= 1) x += __shfl_xor(x, o);
  return x;
}
__device__ __forceinline__ float bcast(float x, int srclane) {
  return __int_as_float(__builtin_amdgcn_readlane(__float_as_int(x), srclane));
}
__device__ __forceinline__ f32x4 mfma16(bf16x8 a, bf16x8 b, f32x4 c) {
  return __builtin_amdgcn_mfma_f32_16x16x32_bf16(a, b, c, 0, 0, 0);
}
__device__ __forceinline__ bf16x8 as_bf8(uint4 v) {
  union { uint4 u; bf16x8 b; } x; x.u = v; return x.b;
}

#define XB_TMO 128
#define XB_XCNT(j) (256 + 64 * (j))
#define XB_XSUB(j) (1280 + 64 * (j))
#define XB_XGEN(j) (2304 + 64 * (j))
#define XB_TOP 3328
#define XB_TOPGEN 3392
#define XCD_BAR_WORDS 3456
#define XB_SPIN_CAP (1u << 22)
#define LAS __attribute__((address_space(3)))
__device__ __forceinline__ unsigned xb_ld(unsigned* p) { return __hip_atomic_load(p, __ATOMIC_RELAXED, __HIP_MEMORY_SCOPE_AGENT); }
__device__ __forceinline__ unsigned xb_add(unsigned* p, unsigned v) { return __hip_atomic_fetch_add(p, v, __ATOMIC_RELAXED, __HIP_MEMORY_SCOPE_AGENT); }
__device__ __forceinline__ unsigned xb_xcc_id() { return (unsigned)__builtin_amdgcn_s_getreg((3 << 11) | 20) & 0xFu; }
#define XB_SPIN(cond, bar) do { unsigned _sp = 0; while (cond) { __builtin_amdgcn_s_sleep(1); \
    if ((++_sp & 255u) == 0u) { if (xb_ld(&(bar)[XB_TMO])) break; if (_sp > XB_SPIN_CAP) { atomicAdd(&(bar)[XB_TMO], 1u); break; } } } } while (0)
struct XcdBarrier { unsigned* bar; unsigned x; volatile LAS unsigned* st; };
__device__ __forceinline__ XcdBarrier xcd_barrier_post(unsigned* bar, volatile LAS unsigned* st) {
  XcdBarrier b; b.bar = bar; b.x = xb_xcc_id(); b.st = st;
  if (threadIdx.x == 0) (void)xb_add(&bar[XB_XCNT(b.x)], 1u);
  return b;
}
__device__ __forceinline__ void xcd_barrier_complete(unsigned* bar, unsigned x, unsigned& nloc, unsigned& nx) {
  const unsigned G = gridDim.x * gridDim.y * gridDim.z;
  unsigned sum, cnt, mine, sp = 0u;
  for (;;) {
    sum = 0u; cnt = 0u; mine = 0u;
#pragma unroll
    for (unsigned j = 0; j < 16; ++j) { const unsigned c = xb_ld(&bar[XB_XCNT(j)]); sum += c; cnt += (c > 0u) ? 1u : 0u; mine = (j == x) ? c : mine; }
    if (sum == G) break;
    __builtin_amdgcn_s_sleep(1);
    if ((++sp & 255u) == 0u) { if (xb_ld(&bar[XB_TMO])) break; if (sp > XB_SPIN_CAP) { atomicAdd(&bar[XB_TMO], 1u); break; } }
  }
  nloc = mine > 0u ? mine : 1u; nx = cnt > 0u ? cnt : 1u;
}
__device__ __forceinline__ void xcd_barrier(const XcdBarrier& b) {
  asm volatile("s_waitcnt vmcnt(0)" ::: "memory");
  __syncthreads();
  if (threadIdx.x == 0) {
    unsigned* bar = b.bar;
    __builtin_amdgcn_s_waitcnt(0);
    unsigned nloc = b.st[0], nx = b.st[1];
    if (nloc == 0u) { xcd_barrier_complete(bar, b.x, nloc, nx); b.st[0] = nloc; b.st[1] = nx; }
    const unsigned old = xb_add(&bar[XB_XSUB(b.x)], 1u);
    const unsigned gen = old / nloc;
    if (old + 1u == (gen + 1u) * nloc) {
      __builtin_amdgcn_fence(__ATOMIC_RELEASE, "agent");
      asm volatile("s_waitcnt vmcnt(0)" ::: "memory");
      const unsigned og = xb_add(&bar[XB_TOP], 1u);
      const unsigned tg = og / nx;
      if (og + 1u == (tg + 1u) * nx) xb_add(&bar[XB_TOPGEN], 1u);
      else XB_SPIN(xb_ld(&bar[XB_TOPGEN]) == tg, bar);
      __builtin_amdgcn_fence(__ATOMIC_ACQUIRE, "agent");
      xb_add(&bar[XB_XGEN(b.x)], 1u);
      asm volatile("s_waitcnt vmcnt(0)" ::: "memory");
    } else {
      XB_SPIN(xb_ld(&bar[XB_XGEN(b.x)]) == gen, bar);
      __builtin_amdgcn_fence(__ATOMIC_ACQUIRE, "agent");
      asm volatile("s_waitcnt vmcnt(0)" ::: "memory");
    }
  }
  __syncthreads();
}

__device__ void transpose_item(const P& p, int i, char* smem) {
  const float* src; bfraw* dst; int K, N, tiles_n, t;
  if (i < 5632) { int m = i / 1408; t = i % 1408; K = 1024; N = 5632; tiles_n = 88;
    src = p.w_gu + (size_t)m * 1024 * 5632; dst = p.wt_gu + (size_t)m * 5632 * 1024; }
  else if (i < 8448) { int j = i - 5632; int m = j / 704; t = j % 704; K = 2816; N = 1024; tiles_n = 16;
    src = p.w_down + (size_t)m * 2816 * 1024; dst = p.wt_down + (size_t)m * 1024 * 2816; }
  else if (i < 9984) { int j = i - 8448; int m = j / 768; t = j % 768; K = 1024; N = 3008; tiles_n = 48;
    src = p.w_in + (size_t)m * 1024 * 3008; dst = p.wt_in + (size_t)m * DINP * 1024; }
  else { int j = i - 9984; int m = j / 256; t = j % 256; K = 1024; N = 1024; tiles_n = 16;
    src = p.w_out + (size_t)m * 1024 * 1024; dst = p.wt_out + (size_t)m * 1024 * 1024; }
  const int k0 = (t / tiles_n) * 64, n0 = (t % tiles_n) * 64;
  float* tile = (float*)smem;
  const int tid = otid();
#pragma unroll
  for (int ii = 0; ii < 4; ++ii) {
    int kk = (tid >> 4) + 16 * ii, n4 = (tid & 15) * 4, n = n0 + n4;
    float4 v = make_float4(0.f, 0.f, 0.f, 0.f);
    if (n < N) {
      const f32x4 t4 = __builtin_nontemporal_load((const f32x4*)(src + (size_t)(k0 + kk) * N + n));
      v = make_float4(t4[0], t4[1], t4[2], t4[3]);
    }
    float* tp = tile + kk * 65 + n4;
    tp[0] = v.x; tp[1] = v.y; tp[2] = v.z; tp[3] = v.w;
  }
  __syncthreads();
  {
    int n = tid >> 2, ks = (tid & 3) * 16;
    float v[16];
#pragma unroll
    for (int j = 0; j < 16; ++j) v[j] = tile[(ks + j) * 65 + n];
    uint4 a, b;
    a.x = pack2(v[0], v[1]); a.y = pack2(v[2], v[3]); a.z = pack2(v[4], v[5]); a.w = pack2(v[6], v[7]);
    b.x = pack2(v[8], v[9]); b.y = pack2(v[10], v[11]); b.z = pack2(v[12], v[13]); b.w = pack2(v[14], v[15]);
    bfraw* dp = dst + (size_t)(n0 + n) * K + k0 + ks;
    *(uint4*)dp = a; *(uint4*)(dp + 8) = b;
  }
  __syncthreads();
}

__device__ void adaln_item(const P& p, int j, char* smem) {
  const int l = j / 144, n0 = (j % 144) * 64, tid = otid();
  float* sc = (float*)smem;
  float* red = sc + 3072;
  for (int idx = tid; idx < 3072; idx += 256) {
    int b = idx >> 10, k = idx & 1023;
    float cv = (b == 0) ? p.c_ctx[k] : p.c[(b - 1) * 1024 + k];
    sc[idx] = cv / (1.f + __expf(-cv));
  }
  __syncthreads();
  const int kq = tid >> 4, c4 = tid & 15;
  float acc[3][4];
#pragma unroll
  for (int b = 0; b < 3; ++b)
#pragma unroll
    for (int e = 0; e < 4; ++e) acc[b][e] = 0.f;
  const float* wp = p.w_ada + (size_t)l * 1024 * 9216 + n0 + c4 * 4;
#pragma unroll 16
  for (int i = 0; i < 64; ++i) {
    int k = kq + 16 * i;
    const f32x4 w4 = __builtin_nontemporal_load((const f32x4*)(wp + (size_t)k * 9216));
    const float4 w = make_float4(w4[0], w4[1], w4[2], w4[3]);
#pragma unroll
    for (int b = 0; b < 3; ++b) {
      float s = sc[b * 1024 + k];
      acc[b][0] += s * w.x; acc[b][1] += s * w.y; acc[b][2] += s * w.z; acc[b][3] += s * w.w;
    }
  }
#pragma unroll
  for (int b = 0; b < 3; ++b)
#pragma unroll
    for (int e = 0; e < 4; ++e) red[(kq * 3 + b) * 64 + c4 * 4 + e] = acc[b][e];
  __syncthreads();
  if (tid < 192) {
    int b = tid >> 6, col = tid & 63;
    float s = 0.f;
#pragma unroll
    for (int q = 0; q < 16; ++q) s += red[(q * 3 + b) * 64 + col];
    const int n = n0 + col, idx = n >> 10, c = n & 1023, sub = idx / 3, kind = idx - 3 * sub;
    float v = s + p.b_ada[l * 9216 + n];
    if (kind == 1) v = p.norm_pre[(size_t)(l * 3 + sub) * 1024 + c] * (1.f + v);
    else if (kind == 2) v = ((sub == 1) ? 1.f : 0.5f) * v * p.norm_post[(size_t)(l * 3 + sub) * 1024 + c];
    p.mods[(size_t)(l * 3 + b) * 9216 + n] = v;
  }
  __syncthreads();
}

__device__ __forceinline__ int early_transpose_id(int e) {
  return e < 1408 ? e : (e < 2112 ? 5632 + (e - 1408) : 8448 + (e - 2112));
}
__device__ __forceinline__ int late_transpose_id(int k) {
  return k < 4224 ? 1408 + k : (k < 6336 ? 6336 + (k - 4224) : (k < 7104 ? 9216 + (k - 6336) : 9984 + (k - 7104)));
}
constexpr int N_EARLY_T = 2880, N_LATE_T = 7616;

__device__ void phase_prologue(const P& p, char* smem, int* s_item) {
  const int nitems = 288 + N_EARLY_T;
  unsigned* ctr = p.bar + XCD_BAR_WORDS + 40;
  for (;;) {
    __syncthreads();
    if (otid() == 0) *s_item = (int)atomicAdd(ctr, 1u);
    __syncthreads();
    const int i = *s_item;
    if (i >= nitems) break;
    if (i < 288) adaln_item(p, i, smem);
    else transpose_item(p, early_transpose_id(i - 288), smem);
  }
}

__device__ __forceinline__ void unpack8(const uint4 u, float4& a, float4& b) {
  a = make_float4(__uint_as_float(u.x << 16), __uint_as_float(u.x & 0xffff0000u), __uint_as_float(u.y << 16), __uint_as_float(u.y & 0xffff0000u));
  b = make_float4(__uint_as_float(u.z << 16), __uint_as_float(u.z & 0xffff0000u), __uint_as_float(u.w << 16), __uint_as_float(u.w & 0xffff0000u));
}
__device__ void phase_rowop(const P& p, int l_post, int i_post, int l_next, int i_next) {
  const int lane = otid() & 63;
  const int gw = (obid() * 256 + otid()) >> 6, nw = gridDim.x * 4;
  for (int row = gw; row < NTOK; row += nw) {
    const int ms = row < NCTX ? 0 : 1 + ((row - NCTX) >> 10);
    float4 x[4];
    if (i_post < 0) {
      const float4* src = (const float4*)(row < NCTX ? p.x_prompt + (size_t)row * D : p.x_sample + (size_t)(row - NCTX) * D);
#pragma unroll
      for (int j = 0; j < 2; ++j) { x[2 * j] = src[j * 128 + lane * 2]; x[2 * j + 1] = src[j * 128 + lane * 2 + 1]; }
    } else {
      const uint4* xs = (const uint4*)(p.XB + (size_t)row * D);
      const uint4* fs = (const uint4*)((const bfraw*)p.F + (size_t)row * D);
      float4 f[4];
      float ss = 0.f;
#pragma unroll
      for (int j = 0; j < 2; ++j) {
        const uint4 xb = xs[j * 64 + lane], fb = fs[j * 64 + lane];
        unpack8(xb, x[2 * j], x[2 * j + 1]);
        unpack8(fb, f[2 * j], f[2 * j + 1]);
      }
#pragma unroll
      for (int j = 0; j < 4; ++j) ss += f[j].x * f[j].x + f[j].y * f[j].y + f[j].z * f[j].z + f[j].w * f[j].w;
      ss = sum64(ss);
      const float rstd = rsqrtf(ss * (1.f / 1024.f) + EPS);
      const float4* gt = (const float4*)(p.mods + (size_t)(l_post * 3 + ms) * 9216 + (3 * i_post + 2) * 1024);
#pragma unroll
      for (int j = 0; j < 4; ++j) {
        const float4 g = gt[(j >> 1) * 128 + lane * 2 + (j & 1)];
        x[j].x += g.x * (f[j].x * rstd);
        x[j].y += g.y * (f[j].y * rstd);
        x[j].z += g.z * (f[j].z * rstd);
        x[j].w += g.w * (f[j].w * rstd);
      }
    }
    if (i_next < 0) {
      float4* xd = (float4*)(p.X + (size_t)row * D);
#pragma unroll
      for (int j = 0; j < 4; ++j) xd[(j >> 1) * 128 + lane * 2 + (j & 1)] = x[j];
    } else {
      uint4* xd = (uint4*)(p.XB + (size_t)row * D);
#pragma unroll
      for (int j = 0; j < 2; ++j) xd[j * 64 + lane] = pack8(x[2 * j], x[2 * j + 1]);
    }
    if (i_next >= 0) {
      float ss = 0.f;
#pragma unroll
      for (int j = 0; j < 4; ++j) ss += x[j].x * x[j].x + x[j].y * x[j].y + x[j].z * x[j].z + x[j].w * x[j].w;
      ss = sum64(ss);
      const float rstd = rsqrtf(ss * (1.f / 1024.f) + EPS);
      const float4* sh = (const float4*)(p.mods + (size_t)(l_next * 3 + ms) * 9216 + (3 * i_next) * 1024);
      const float4* sc = (const float4*)(p.mods + (size_t)(l_next * 3 + ms) * 9216 + (3 * i_next + 1) * 1024);
      uint4* hd = (uint4*)(p.H + (size_t)row * D);
#pragma unroll
      for (int j = 0; j < 2; ++j) {
        float4 h[2];
#pragma unroll
        for (int e = 0; e < 2; ++e) {
          const int q = j * 128 + lane * 2 + e;
          const float4 s = sh[q], c = sc[q];
          const float4 xv = x[2 * j + e];
          h[e] = make_float4(xv.x * rstd * c.x + s.x, xv.y * rstd * c.y + s.y, xv.z * rstd * c.z + s.z, xv.w * rstd * c.w + s.w);
        }
        hd[j * 64 + lane] = pack8(h[0], h[1]);
      }
    }
  }
}

enum { EPI_SWIGLU = 0, EPI_F32 = 1, EPI_Z = 2 };

template <int EPI, int MODE = 0>
__device__ __forceinline__ void gemm_tile(const P& p, const bfraw* __restrict__ A, const bfraw* __restrict__ WT,
                                          int K, int tm, int tn, int l, char* smem) {
  const int tid = otid(), lane = tid & 63, wid = tid >> 6;
  const int fr = lane & 15, fq = lane >> 4;
  const int wr = wid >> 1, wc = wid & 1;
  char* sA = smem;
  char* sB = smem + 16384;
  const int lr = tid >> 3, lc = tid & 7;
  const bfraw* ap = A + (size_t)(tm * 128 + lr) * K + lc * 8;
  const bfraw* bp;
  size_t bstep;
  const int pcol = 8 * ((lr & 15) >> 2) + (lr & 3);
  size_t bo1, bo2, bo3;
  if (EPI == EPI_SWIGLU) {
    bp = WT + (size_t)((lr >> 4) * DFF + tn * 64 + pcol) * K + lc * 8;
    bo1 = (size_t)4 * K; bo2 = (size_t)32 * K; bo3 = (size_t)36 * K;
  } else {
    bp = WT + (size_t)(tn * 128 + pcol + 4 * (lr >> 4)) * K + lc * 8;
    bo1 = (size_t)32 * K; bo2 = (size_t)64 * K; bo3 = (size_t)96 * K;
  }
  bstep = 0; (void)bstep;
  const size_t astep = (size_t)32 * K;
  const int wofs = lr * 128 + ((lc ^ ((lr >> 1) & 7)) << 4);

  f32x4 acc[4][4];
#pragma unroll
  for (int m = 0; m < 4; ++m)
#pragma unroll
    for (int n = 0; n < 4; ++n) acc[m][n] = (f32x4){0.f, 0.f, 0.f, 0.f};

  uint4 ra0, ra1, ra2, ra3, rb0, rb1, rb2, rb3;
#define GLOAD(ko)                                                                                      \
  ra0 = *(const uint4*)(ap + (ko)); ra1 = *(const uint4*)(ap + astep + (ko));                          \
  ra2 = *(const uint4*)(ap + 2 * astep + (ko)); ra3 = *(const uint4*)(ap + 3 * astep + (ko));          \
  rb0 = *(const uint4*)(bp + (ko)); rb1 = *(const uint4*)(bp + bo1 + (ko));                            \
  rb2 = *(const uint4*)(bp + bo2 + (ko)); rb3 = *(const uint4*)(bp + bo3 + (ko));
  GLOAD(0)
  const int nkt = K >> 6;
  const int sw = (fr >> 1) & 7;
  for (int kt = 0; kt < nkt; ++kt) {
    __syncthreads();
    *(uint4*)(sA + wofs) = ra0; *(uint4*)(sA + wofs + 4096) = ra1;
    *(uint4*)(sA + wofs + 8192) = ra2; *(uint4*)(sA + wofs + 12288) = ra3;
    *(uint4*)(sB + wofs) = rb0; *(uint4*)(sB + wofs + 4096) = rb1;
    *(uint4*)(sB + wofs + 8192) = rb2; *(uint4*)(sB + wofs + 12288) = rb3;
    __syncthreads();
    if (MODE != 1 && kt + 1 < nkt) {
      const int ko = (kt + 1) * 64;
      GLOAD(ko)
    }
#pragma unroll
    for (int s2 = 0; s2 < 2; ++s2) {
      bf16x8 af[4], bf[4];
      const int co = ((s2 * 4 + fq) ^ sw) << 4;
#pragma unroll
      for (int m = 0; m < 4; ++m) af[m] = *(const bf16x8*)(sA + (wr * 64 + m * 16 + fr) * 128 + co);
#pragma unroll
      for (int n = 0; n < 4; ++n) bf[n] = *(const bf16x8*)(sB + (wc * 64 + n * 16 + fr) * 128 + co);
#pragma unroll
      for (int m = 0; m < 4; ++m)
#pragma unroll
        for (int n = 0; n < 4; ++n) {
          if (MODE == 2) { asm volatile("" ::"v"(af[m]), "v"(bf[n])); }
          else acc[m][n] = mfma16(bf[n], af[m], acc[m][n]);
        }
    }
  }
#undef GLOAD
  const int row0 = tm * 128 + wr * 64 + fr;
  if (EPI == EPI_SWIGLU) {
#pragma unroll
    for (int m = 0; m < 4; ++m) {
      float4 a[2];
#pragma unroll
      for (int q = 0; q < 2; ++q) {
        const f32x4 g = acc[m][2 * q], u = acc[m][2 * q + 1];
        a[q] = make_float4(g[0] * __builtin_amdgcn_rcpf(1.f + __expf(-g[0])) * u[0], g[1] * __builtin_amdgcn_rcpf(1.f + __expf(-g[1])) * u[1],
                           g[2] * __builtin_amdgcn_rcpf(1.f + __expf(-g[2])) * u[2], g[3] * __builtin_amdgcn_rcpf(1.f + __expf(-g[3])) * u[3]);
      }
      *(uint4*)((MODE ? (bfraw*)p.PREP : p.ACT) + (size_t)(row0 + m * 16) * DFF + tn * 64 + wc * 32 + fq * 8) = pack8(a[0], a[1]);
    }
  } else if (EPI == EPI_F32) {
#pragma unroll
    for (int m = 0; m < 4; ++m)
#pragma unroll
      for (int g2 = 0; g2 < 2; ++g2) {
        const f32x4 lo = acc[m][2 * g2], hi = acc[m][2 * g2 + 1];
        *(uint4*)((bfraw*)p.F + (size_t)(row0 + m * 16) * D + tn * 128 + wc * 64 + g2 * 32 + fq * 8) =
            pack8(make_float4(lo[0], lo[1], lo[2], lo[3]), make_float4(hi[0], hi[1], hi[2], hi[3]));
      }
  } else {
#pragma unroll
    for (int g2 = 0; g2 < 2; ++g2) {
      const int col = tn * 128 + wc * 64 + g2 * 32 + fq * 8;
      if (col < DIN) {
#pragma unroll
        for (int m = 0; m < 4; ++m) {
          const int row = row0 + m * 16;
          if (col < 512) {
            const f32x4 lo = acc[m][2 * g2], hi = acc[m][2 * g2 + 1];
            *(uint4*)(p.QB + (size_t)row * 512 + col) = pack8(make_float4(lo[0], lo[1], lo[2], lo[3]), make_float4(hi[0], hi[1], hi[2], hi[3]));
          } else if (row < NCTX && col >= 512 && col < 1536) {
            const int b = row >> 8, t = row & 255;
            float* dst = ((col < 1024) ? p.out_k : p.out_v) + ((size_t)(b * 2 + l) * 256 + t) * 512 + (col & 511);
            *(f32x4*)dst = acc[m][2 * g2]; *(f32x4*)(dst + 4) = acc[m][2 * g2 + 1];
          } else {
            float* zp = p.Z + (size_t)row * DIN + col;
            *(f32x4*)zp = acc[m][2 * g2]; *(f32x4*)(zp + 4) = acc[m][2 * g2 + 1];
          }
        }
      }
    }
  }
}

__device__ __forceinline__ void gemm_tile_half(const P& p, const bfraw* __restrict__ A, const bfraw* __restrict__ WT,
                                               int K, int tm, int tn, int nh, char* smem) {
  const int tid = otid(), lane = tid & 63, wid = tid >> 6;
  const int fr = lane & 15, fq = lane >> 4;
  const int wr = wid >> 1, wc = wid & 1;
  char* sA = smem;
  char* sB = smem + 16384;
  const int lr = tid >> 3, lc = tid & 7;
  const bfraw* ap = A + (size_t)(tm * 128 + lr) * K + lc * 8;
  const bfraw* bp = WT + (size_t)(tn * 128 + nh * 64 + 8 * ((lr & 15) >> 2) + 4 * (lr >> 4) + (lr & 3)) * K + lc * 8;
  const size_t astep = (size_t)32 * K;
  const int wofs = lr * 128 + ((lc ^ ((lr >> 1) & 7)) << 4);
  f32x4 acc[4][2];
#pragma unroll
  for (int m = 0; m < 4; ++m)
#pragma unroll
    for (int n = 0; n < 2; ++n) acc[m][n] = (f32x4){0.f, 0.f, 0.f, 0.f};
  uint4 ra0, ra1, ra2, ra3, rb0, rb1;
#define GLOADH(ko)                                                                                     \
  ra0 = *(const uint4*)(ap + (ko)); ra1 = *(const uint4*)(ap + astep + (ko));                          \
  ra2 = *(const uint4*)(ap + 2 * astep + (ko)); ra3 = *(const uint4*)(ap + 3 * astep + (ko));          \
  rb0 = *(const uint4*)(bp + (ko)); rb1 = *(const uint4*)(bp + astep + (ko));
  GLOADH(0)
  const int nkt = K >> 6;
  const int sw = (fr >> 1) & 7;
  for (int kt = 0; kt < nkt; ++kt) {
    __syncthreads();
    *(uint4*)(sA + wofs) = ra0; *(uint4*)(sA + wofs + 4096) = ra1;
    *(uint4*)(sA + wofs + 8192) = ra2; *(uint4*)(sA + wofs + 12288) = ra3;
    *(uint4*)(sB + wofs) = rb0; *(uint4*)(sB + wofs + 4096) = rb1;
    __syncthreads();
    if (kt + 1 < nkt) {
      const int ko = (kt + 1) * 64;
      GLOADH(ko)
    }
#pragma unroll
    for (int s2 = 0; s2 < 2; ++s2) {
      bf16x8 af[4], bf[2];
      const int co = ((s2 * 4 + fq) ^ sw) << 4;
#pragma unroll
      for (int m = 0; m < 4; ++m) af[m] = *(const bf16x8*)(sA + (wr * 64 + m * 16 + fr) * 128 + co);
#pragma unroll
      for (int n = 0; n < 2; ++n) bf[n] = *(const bf16x8*)(sB + (wc * 32 + n * 16 + fr) * 128 + co);
#pragma unroll
      for (int m = 0; m < 4; ++m)
#pragma unroll
        for (int n = 0; n < 2; ++n) acc[m][n] = mfma16(bf[n], af[m], acc[m][n]);
    }
  }
#undef GLOADH
  const int row0 = tm * 128 + wr * 64 + fr;
#pragma unroll
  for (int m = 0; m < 4; ++m) {
    const f32x4 lo = acc[m][0], hi = acc[m][1];
    *(uint4*)((bfraw*)p.F + (size_t)(row0 + m * 16) * D + tn * 128 + nh * 64 + wc * 32 + fq * 8) =
        pack8(make_float4(lo[0], lo[1], lo[2], lo[3]), make_float4(hi[0], hi[1], hi[2], hi[3]));
  }
}

__device__ void phase_gemm_n1024(const P& p, const bfraw* A, const bfraw* WT, int K, int l, char* smem) {
  const int bid = obid();
  const int x = bid & 7, j = bid >> 3;
  const int per = gridDim.x >> 3;
  if (per != 96) {
    const int id0 = (640 * x) >> 3, id1 = (640 * (x + 1)) >> 3;
    for (int id = id0 + j; id < id1; id += per) gemm_tile<EPI_F32, 0>(p, A, WT, K, (id >> 6) * 8 + (id & 7), (id & 63) >> 3, l, smem);
    return;
  }
  const int id0 = 80 * x;
  if (j < 64) {
    const int id = id0 + j;
    gemm_tile<EPI_F32, 0>(p, A, WT, K, (id >> 6) * 8 + (id & 7), (id & 63) >> 3, l, smem);
  } else {
    const int id = id0 + 64 + ((j - 64) >> 1);
    gemm_tile_half(p, A, WT, K, (id >> 6) * 8 + (id & 7), (id & 63) >> 3, (j - 64) & 1, smem);
  }
}

template <int EPI, int MODE = 0>
__device__ void phase_gemm(const P& p, const bfraw* A, const bfraw* WT, int K, int tiles_n, int l, char* smem) {
  const int bid = obid();
  const int x = bid & 7, j = bid >> 3;
  const int per = gridDim.x >> 3;
  const int ntiles = 80 * tiles_n;
  const int id0 = (ntiles * x) >> 3, id1 = (ntiles * (x + 1)) >> 3;
  const int group_sz = 8 * tiles_n;
  for (int id = id0 + j; id < id1; id += per) {
    const int g = id / group_sz, r = id - g * group_sz;
    gemm_tile<EPI, MODE>(p, A, WT, K, g * 8 + (r & 7), r >> 3, l, smem);
  }
}

__device__ void phase_prep(const P& p, int l) {
  constexpr int NT = 4;
  const int lane = otid() & 63;
  const int gw = (obid() * 256 + otid()) >> 6, nw = gridDim.x * 4;
  const int c = lane * 4;
  const float4 kkw = *(const float4*)(p.k_k + l * 256 + c);
  const float4 kaw = *(const float4*)(p.k_a + l * 256 + c);
  for (int tok0 = gw * NT; tok0 < NTOK; tok0 += nw * NT) {
    float4 k4[NT], kk[NT];
    float tw[NT], al[NT];
#pragma unroll
    for (int t = 0; t < NT; ++t) {
      const float* z = p.Z + (size_t)(tok0 + t) * DIN;
      k4[t] = *(const float4*)(z + 2304 + c);
      kk[t] = make_float4(k4[t].x * kkw.x, k4[t].y * kkw.y, k4[t].z * kkw.z, k4[t].w * kkw.w);
      float ss = kk[t].x * kk[t].x + kk[t].y * kk[t].y + kk[t].z * kk[t].z + kk[t].w * kk[t].w;
      ss = sum16(ss);
      const float inv = rsqrtf(ss + EPS);
      kk[t].x *= inv; kk[t].y *= inv; kk[t].z *= inv; kk[t].w *= inv;
      tw[t] = tanhf(z[2816 + lane]);
      al[t] = z[2880 + lane];
      *(float4*)(p.PREP + (size_t)(tok0 + t) * NPREP + c) = kk[t];
    }
#pragma unroll
    for (int dir = 0; dir < 2; ++dir) {
      const float4 w0v = *(const float4*)(p.w0 + (l * 2 + dir) * 256 + c);
      const float4 a0v = *(const float4*)(p.a0 + (l * 2 + dir) * 256 + c);
      float4 wa[NT], aa[NT];
#pragma unroll
      for (int t = 0; t < NT; ++t) { wa[t] = w0v; aa[t] = a0v; }
      const float* w2p = p.w2 + (size_t)(l * 2 + dir) * 32 * 256 + c;
      const float* a2p = p.a2 + (size_t)(l * 2 + dir) * 32 * 256 + c;
#pragma unroll 2
      for (int r = 0; r < 32; ++r) {
        const float4 w2v = *(const float4*)(w2p + r * 256);
        const float4 a2v = *(const float4*)(a2p + r * 256);
#pragma unroll
        for (int t = 0; t < NT; ++t) {
          const float tv = bcast(tw[t], dir * 32 + r), av = bcast(al[t], dir * 32 + r);
          wa[t].x += tv * w2v.x; wa[t].y += tv * w2v.y; wa[t].z += tv * w2v.z; wa[t].w += tv * w2v.w;
          aa[t].x += av * a2v.x; aa[t].y += av * a2v.y; aa[t].z += av * a2v.z; aa[t].w += av * a2v.w;
        }
      }
      const float ce = -0.6065306597126334f;
#pragma unroll
      for (int t = 0; t < NT; ++t) {
        float* pr = p.PREP + (size_t)(tok0 + t) * NPREP;
        float4 dec = make_float4(__expf(ce * sigmoidf_(wa[t].x)), __expf(ce * sigmoidf_(wa[t].y)),
                                 __expf(ce * sigmoidf_(wa[t].z)), __expf(ce * sigmoidf_(wa[t].w)));
        float4 a = make_float4(sigmoidf_(aa[t].x), sigmoidf_(aa[t].y), sigmoidf_(aa[t].z), sigmoidf_(aa[t].w));
        *(float4*)(pr + (1 + 2 * dir) * 256 + c) = dec;
        *(float4*)(pr + (2 + 2 * dir) * 256 + c) = a;
      }
    }
  }
}

__device__ void scan_item(const P& p, int l, int item, char* smem) {
  const int tid = otid(), lane = tid & 63, wid = tid >> 6;
  const bool lat = item < 64;
  const int j = lat ? item : item - 64;
  const int quarter = j & 3, dir = (j >> 2) & 1, h = (j >> 3) & 3, b = j >> 5;
  const int T = lat ? 1024 : 256;
  const int base = lat ? NCTX + b * 1024 : b * 256;
  const int kq = lane & 15, v = quarter * 16 + wid * 4 + (lane >> 4);
  float* buf = (float*)smem;
  f32x2 S01 = {0.f, 0.f}, S23 = {0.f, 0.f};
  if (lat) {
    const float* sp = p.state + ((((size_t)(b * 2 + l) * 2 + dir) * 4 + h) * 64 + v) * 64 + kq * 4;
    const float4 s0 = *(const float4*)sp;
    S01.x = s0.x; S01.y = s0.y; S23.x = s0.z; S23.y = s0.w;
  }
  const int nch = T >> 4;
  const int lst = tid >> 4, lc4 = tid & 15;
  const int lcol = h * 64 + lc4 * 4;
  const float4 ka4 = *(const float4*)(p.k_a + l * 256 + lcol);
  float4 x0, x1, x2, x3, x4, x5, y0, y1, y2, y3, y4, y5;
#define SLOAD(G, cb)                                                                                \
  {                                                                                                 \
    const int tl_ = (cb) + lst;                                                                     \
    const int tok_ = base + (dir ? T - 1 - tl_ : tl_);                                              \
    const float* zr_ = p.Z + (size_t)tok_ * DIN + lcol;                                             \
    const float* pr_ = p.PREP + (size_t)tok_ * NPREP + lcol;                                        \
    G##0 = *(const float4*)(zr_ + 2048);                                                            \
    G##1 = *(const float4*)(pr_ + (1 + 2 * dir) * 256);                                             \
    G##2 = *(const float4*)(zr_ + 2304);                                                            \
    G##3 = *(const float4*)(pr_);                                                                   \
    G##4 = *(const float4*)(pr_ + (2 + 2 * dir) * 256);                                             \
    G##5 = *(const float4*)(zr_ + 2560);                                                            \
  }
#define SSTORE(G, dst)                                                                              \
  {                                                                                                 \
    float* d_ = (dst) + lst * 384 + lc4 * 4;                                                        \
    const float4 k_ = G##2, n_ = G##3, s_ = G##4;                                                   \
    *(float4*)(d_) = G##0; *(float4*)(d_ + 64) = G##1;                                              \
    *(float4*)(d_ + 128) = make_float4(k_.x * (1.f + (s_.x - 1.f) * ka4.x), k_.y * (1.f + (s_.y - 1.f) * ka4.y), \
                                       k_.z * (1.f + (s_.z - 1.f) * ka4.z), k_.w * (1.f + (s_.w - 1.f) * ka4.w)); \
    *(float4*)(d_ + 192) = make_float4(-n_.x, -n_.y, -n_.z, -n_.w);                                 \
    *(float4*)(d_ + 256) = make_float4(n_.x * s_.x, n_.y * s_.y, n_.z * s_.z, n_.w * s_.w);         \
    *(float4*)(d_ + 320) = G##5;                                                                    \
  }
  __syncthreads();
  SLOAD(x, 0)
  SSTORE(x, buf)
  __syncthreads();
  SLOAD(x, 16)
  SLOAD(y, 32)
  float* yb = p.Y + (size_t)dir * NTOK * 256 + h * 64 + v;
  const int kq4 = kq * 4;
  float ykeep = 0.f;
#define SI_LOAD(P_, bs_)                                                                               \
  P_##r = *(const f32x4*)((bs_) + kq4); P_##w = *(const f32x4*)((bs_) + 64 + kq4);                     \
  P_##k = *(const f32x4*)((bs_) + 128 + kq4); P_##a = *(const f32x4*)((bs_) + 192 + kq4);              \
  P_##b = *(const f32x4*)((bs_) + 256 + kq4); P_##vv = (bs_)[320 + v];
#define SI_DECL(P_) f32x4 P_##r, P_##w, P_##k, P_##a, P_##b; float P_##vv;
#define LO2(x) __builtin_shufflevector(x, x, 0, 1)
#define HI2(x) __builtin_shufflevector(x, x, 2, 3)
#define SI_STEP(P_, st_)                                                                               \
  {                                                                                                    \
    f32x2 t1 = S01 * LO2(P_##a); t1 = S23 * HI2(P_##a) + t1;                                           \
    const float sa = sum16(t1.x + t1.y);                                                               \
    const f32x2 sa2 = {sa, sa}, vv2 = {P_##vv, P_##vv};                                                \
    S01 = S01 * LO2(P_##w) + (sa2 * LO2(P_##b) + vv2 * LO2(P_##k));                                    \
    S23 = S23 * HI2(P_##w) + (sa2 * HI2(P_##b) + vv2 * HI2(P_##k));                                    \
    f32x2 u1 = S01 * LO2(P_##r); u1 = S23 * HI2(P_##r) + u1;                                           \
    const float y = sum16(u1.x + u1.y);                                                                \
    ykeep = (kq == (st_)) ? y : ykeep;                                                                 \
  }
  SI_DECL(e_) SI_DECL(o_) SI_DECL(t_)
  __builtin_amdgcn_s_setprio(3);
#define CHUNK_STEPS(cb_, ch_)                                                                          \
  {                                                                                                    \
    SI_LOAD(e_, cb_)                                                                                   \
    SI_LOAD(o_, (cb_) + 384)                                                                           \
    SI_LOAD(t_, (cb_) + 2 * 384)                                                                   \
    SI_STEP(e_, 0)                                                                                    \
    SI_LOAD(e_, (cb_) + 3 * 384)                                                                   \
    SI_STEP(o_, 1)                                                                                    \
    SI_LOAD(o_, (cb_) + 4 * 384)                                                                   \
    SI_STEP(t_, 2)                                                                                    \
    SI_LOAD(t_, (cb_) + 5 * 384)                                                                   \
    SI_STEP(e_, 3)                                                                                    \
    SI_LOAD(e_, (cb_) + 6 * 384)                                                                   \
    SI_STEP(o_, 4)                                                                                    \
    SI_LOAD(o_, (cb_) + 7 * 384)                                                                   \
    SI_STEP(t_, 5)                                                                                    \
    SI_LOAD(t_, (cb_) + 8 * 384)                                                                   \
    SI_STEP(e_, 6)                                                                                    \
    SI_LOAD(e_, (cb_) + 9 * 384)                                                                   \
    SI_STEP(o_, 7)                                                                                    \
    SI_LOAD(o_, (cb_) + 10 * 384)                                                                   \
    SI_STEP(t_, 8)                                                                                    \
    SI_LOAD(t_, (cb_) + 11 * 384)                                                                   \
    SI_STEP(e_, 9)                                                                                    \
    SI_LOAD(e_, (cb_) + 12 * 384)                                                                   \
    SI_STEP(o_, 10)                                                                                    \
    SI_LOAD(o_, (cb_) + 13 * 384)                                                                   \
    SI_STEP(t_, 11)                                                                                    \
    SI_LOAD(t_, (cb_) + 14 * 384)                                                                   \
    SI_STEP(e_, 12)                                                                                    \
    SI_LOAD(e_, (cb_) + 15 * 384)                                                                   \
    SI_STEP(o_, 13)                                                                                    \
    SI_STEP(t_, 14)                                                                                    \
    SI_STEP(e_, 15)                                                                                    \
    const int tl = (ch_) * 16 + kq;                                                                    \
    const int tok = base + (dir ? T - 1 - tl : tl);                                                    \
    yb[(size_t)tok * 256] = ykeep;                                                                     \
  }
  float* buf1 = buf + 16 * 384;
  for (int ch = 0; ch < nch; ch += 2) {
    CHUNK_STEPS(buf, ch)
    SSTORE(x, buf1)
    __syncthreads();
    if (ch + 3 < nch) { SLOAD(x, (ch + 3) * 16) }
    CHUNK_STEPS(buf1, ch + 1)
    if (ch + 2 < nch) { SSTORE(y, buf) }
    __syncthreads();
    if (ch + 4 < nch) { SLOAD(y, (ch + 4) * 16) }
  }
#undef CHUNK_STEPS
  __builtin_amdgcn_s_setprio(0);
#undef SI_LOAD
#undef SI_DECL
#undef SI_STEP
#undef LO2
#undef HI2
#undef SLOAD
#undef SSTORE
  if (!lat) {
    float* dp = p.out_state + ((((size_t)(b * 2 + l) * 2 + dir) * 4 + h) * 64 + v) * 64 + kq * 4;
    *(float4*)dp = make_float4(S01.x, S01.y, S23.x, S23.y);
  }
}

__device__ void scan_item8(const P& p, int l, int item, char* smem) {
  const int tid = otid(), lane = tid & 63, wid = tid >> 6;
  const bool lat = false;
  const int j = item;
  const int half = j & 1, dir = (j >> 1) & 1, h = (j >> 2) & 3, b = j >> 4;
  const int T = lat ? 1024 : 256;
  const int base = lat ? NCTX + b * 1024 : b * 256;
  const int kq = lane & 7, v = half * 32 + wid * 8 + (lane >> 3);
  float* buf = (float*)smem;
  float S[8];
  if (lat) {
    const float* sp = p.state + ((((size_t)(b * 2 + l) * 2 + dir) * 4 + h) * 64 + v) * 64 + kq * 8;
    float4 s0 = *(const float4*)sp, s1 = *(const float4*)(sp + 4);
    S[0] = s0.x; S[1] = s0.y; S[2] = s0.z; S[3] = s0.w; S[4] = s1.x; S[5] = s1.y; S[6] = s1.z; S[7] = s1.w;
  } else {
#pragma unroll
    for (int i = 0; i < 8; ++i) S[i] = 0.f;
  }
  const int nch = T >> 4;
  const int lst = tid >> 4, lc4 = tid & 15;
  const int lcol = h * 64 + lc4 * 4;
  const float4 ka4 = *(const float4*)(p.k_a + l * 256 + lcol);
  float4 g0, g1, g2, g3, g4, g5;
#define SLOAD(cb)                                                                                   \
  {                                                                                                 \
    const int tl_ = (cb) + lst;                                                                     \
    const int tok_ = base + (dir ? T - 1 - tl_ : tl_);                                              \
    const float* zr_ = p.Z + (size_t)tok_ * DIN + lcol;                                             \
    const float* pr_ = p.PREP + (size_t)tok_ * NPREP + lcol;                                        \
    g0 = *(const float4*)(zr_ + 2048);                                                              \
    g1 = *(const float4*)(pr_ + (1 + 2 * dir) * 256);                                               \
    g2 = *(const float4*)(zr_ + 2304);                                                              \
    g3 = *(const float4*)(pr_);                                                                     \
    g4 = *(const float4*)(pr_ + (2 + 2 * dir) * 256);                                               \
    g5 = *(const float4*)(zr_ + 2560);                                                              \
  }
#define SSTORE(dst)                                                                                 \
  {                                                                                                 \
    float* d_ = (dst) + lst * 384 + lc4 * 4;                                                        \
    *(float4*)(d_) = g0; *(float4*)(d_ + 64) = g1;                                                  \
    *(float4*)(d_ + 128) = make_float4(g2.x * (1.f + (g4.x - 1.f) * ka4.x), g2.y * (1.f + (g4.y - 1.f) * ka4.y), \
                                       g2.z * (1.f + (g4.z - 1.f) * ka4.z), g2.w * (1.f + (g4.w - 1.f) * ka4.w)); \
    *(float4*)(d_ + 192) = make_float4(-g3.x, -g3.y, -g3.z, -g3.w);                                 \
    *(float4*)(d_ + 256) = make_float4(g3.x * g4.x, g3.y * g4.y, g3.z * g4.z, g3.w * g4.w);         \
    *(float4*)(d_ + 320) = g5;                                                                      \
  }
  __syncthreads();
  SLOAD(0)
  SSTORE(buf)
  __syncthreads();
  float* yb = p.Y + (size_t)dir * NTOK * 256 + h * 64 + v;
  const int kq8 = kq * 8;
  float ykeep = 0.f;
#define SI_LOAD(P_, bs_)                                                                               \
  P_##r0 = *(const f32x4*)((bs_) + kq8); P_##r1 = *(const f32x4*)((bs_) + kq8 + 4);                    \
  P_##w0 = *(const f32x4*)((bs_) + 64 + kq8); P_##w1 = *(const f32x4*)((bs_) + 64 + kq8 + 4);          \
  P_##k0 = *(const f32x4*)((bs_) + 128 + kq8); P_##k1 = *(const f32x4*)((bs_) + 128 + kq8 + 4);        \
  P_##a0 = *(const f32x4*)((bs_) + 192 + kq8); P_##a1 = *(const f32x4*)((bs_) + 192 + kq8 + 4);        \
  P_##b0 = *(const f32x4*)((bs_) + 256 + kq8); P_##b1 = *(const f32x4*)((bs_) + 256 + kq8 + 4);        \
  P_##vv = (bs_)[320 + v];
#define SI_DECL(P_) f32x4 P_##r0, P_##r1, P_##w0, P_##w1, P_##k0, P_##k1, P_##a0, P_##a1, P_##b0, P_##b1; float P_##vv;
#define LO2(x) __builtin_shufflevector(x, x, 0, 1)
#define HI2(x) __builtin_shufflevector(x, x, 2, 3)
#define SI_STEP(P_, st_)                                                                               \
  {                                                                                                    \
    f32x2 t1 = S01 * LO2(P_##a0); t1 = S23 * HI2(P_##a0) + t1;                                         \
    f32x2 t2 = S45 * LO2(P_##a1); t2 = S67 * HI2(P_##a1) + t2;                                         \
    t1 = t1 + t2;                                                                                      \
    float sa = sum8(t1.x + t1.y);                                                                      \
    const f32x2 sa2 = {sa, sa}, vv2 = {P_##vv, P_##vv};                                                \
    S01 = S01 * LO2(P_##w0) + (sa2 * LO2(P_##b0) + vv2 * LO2(P_##k0));                                 \
    S23 = S23 * HI2(P_##w0) + (sa2 * HI2(P_##b0) + vv2 * HI2(P_##k0));                                 \
    S45 = S45 * LO2(P_##w1) + (sa2 * LO2(P_##b1) + vv2 * LO2(P_##k1));                                 \
    S67 = S67 * HI2(P_##w1) + (sa2 * HI2(P_##b1) + vv2 * HI2(P_##k1));                                 \
    f32x2 u1 = S01 * LO2(P_##r0); u1 = S23 * HI2(P_##r0) + u1;                                         \
    f32x2 u2 = S45 * LO2(P_##r1); u2 = S67 * HI2(P_##r1) + u2;                                         \
    u1 = u1 + u2;                                                                                      \
    const float y = sum8(u1.x + u1.y);                                                                 \
    ykeep = (kq == ((st_)&7)) ? y : ykeep;                                                             \
    if (((st_)&7) == 7) {                                                                              \
      const int tl = ch * 16 + ((st_)&8) + kq;                                                         \
      const int tok = base + (dir ? T - 1 - tl : tl);                                                  \
      yb[(size_t)tok * 256] = ykeep;                                                                   \
    }                                                                                                  \
  }
  f32x2 S01 = {S[0], S[1]}, S23 = {S[2], S[3]}, S45 = {S[4], S[5]}, S67 = {S[6], S[7]};
  SI_DECL(e_) SI_DECL(o_)
  __builtin_amdgcn_s_setprio(2);
  for (int ch = 0; ch < nch; ++ch) {
    const int cur = ch & 1;
    if (ch + 1 < nch) { SLOAD((ch + 1) * 16) }
    const float* cb = buf + cur * (16 * 384);
    SI_LOAD(e_, cb)
#pragma unroll 1
    for (int st = 0; st < 16; st += 2) {
      SI_LOAD(o_, cb + (st + 1) * 384)
      SI_STEP(e_, st)
      if (st + 2 < 16) { SI_LOAD(e_, cb + (st + 2) * 384) }
      SI_STEP(o_, st + 1)
    }
    if (ch + 1 < nch) {
      float* nb = buf + (cur ^ 1) * (16 * 384);
      SSTORE(nb)
    }
    __syncthreads();
  }
  __builtin_amdgcn_s_setprio(0);
#undef SI_LOAD
#undef SI_DECL
#undef SI_STEP
#undef LO2
#undef HI2
  S[0] = S01.x; S[1] = S01.y; S[2] = S23.x; S[3] = S23.y; S[4] = S45.x; S[5] = S45.y; S[6] = S67.x; S[7] = S67.y;
#undef SLOAD
#undef SSTORE
  if (!lat) {
    float* dp = p.out_state + ((((size_t)(b * 2 + l) * 2 + dir) * 4 + h) * 64 + v) * 64 + kq * 8;
    *(float4*)dp = make_float4(S[0], S[1], S[2], S[3]);
    *(float4*)(dp + 4) = make_float4(S[4], S[5], S[6], S[7]);
  }
}

__device__ void attn_unit(const P& p, int l, int unit, char* smem) {
  const int tid = otid(), lane = tid & 63, wid = tid >> 6;
  const int fr = lane & 15, fq = lane >> 4;
  char* sK = smem;
  bfraw* sVt = (bfraw*)(smem + 16384);
  bfraw* sP = (bfraw*)(smem + 16384 + 17408);
  float* sRpb = (float*)(smem + 16384 + 2 * 17408);
  const bool na = unit >= 1024;
  int b, h, qtok0, r = 0, rs = 0;
  __syncthreads();
  if (!na) { const int qb = unit & 3; h = (unit >> 2) & 7; b = unit >> 5; qtok0 = b * 256 + qb * 64; }
  else {
    const int u = unit - 1024; r = u & 15; h = (u >> 4) & 7; b = u >> 7;
    qtok0 = NCTX + b * 1024 + r * 64; rs = min(max(r - 4, 0), 8);
    for (int i = tid; i < 465; i += 256) sRpb[i] = p.rpb[(size_t)(l * 8 + h) * 465 + i];
  }
  bf16x8 qf[2];
  {
    const bfraw* qp = p.QB + (size_t)(qtok0 + wid * 16 + fr) * 512 + h * 64 + fq * 8;
#pragma unroll
    for (int s = 0; s < 2; ++s) qf[s] = as_bf8(*(const uint4*)(qp + s * 32));
  }
  float m_run[4], l_run[4];
  f32x4 o[4];
#pragma unroll
  for (int j = 0; j < 4; ++j) { m_run[j] = -1e30f; l_run[j] = 0.f; o[j] = (f32x4){0.f, 0.f, 0.f, 0.f}; }
  const int nseg = na ? 6 : 2;
  const int sw = (fr >> 1) & 7;
  for (int seg = 0; seg < nseg; ++seg) {
    const float *kbase, *vbase;
    int kstride, krow0 = 0;
    bool local = false;
    if (!na) {
      const size_t i0 = ((size_t)(b * 2 + l) * 256 + seg * 128) * 512 + h * 64;
      kbase = p.out_k + i0; vbase = p.out_v + i0; kstride = 512;
    } else if (seg < 2) {
      const size_t i0 = ((size_t)(b * 2 + l) * 256 + seg * 128) * 512 + h * 64;
      kbase = p.cache_k + i0; vbase = p.cache_v + i0; kstride = 512;
    } else {
      krow0 = rs + 2 * (seg - 2);
      const size_t t0 = (size_t)(NCTX + b * 1024 + krow0 * 64) * DIN + h * 64;
      kbase = p.Z + t0 + 512; vbase = p.Z + t0 + 1024; kstride = DIN; local = true;
    }
    __syncthreads();
    {
      const int key = tid >> 1, hf = tid & 1;
      const float* kp = kbase + (size_t)key * kstride + hf * 32;
      const float* vp = vbase + (size_t)key * kstride + hf * 32;
#pragma unroll
      for (int c = 0; c < 4; ++c) {
        float4 x0 = *(const float4*)(kp + c * 8), x1 = *(const float4*)(kp + c * 8 + 4);
        const int chunk = hf * 4 + c;
        *(uint4*)(sK + key * 128 + ((chunk ^ ((key >> 1) & 7)) << 4)) = pack8(x0, x1);
      }
#pragma unroll
      for (int c = 0; c < 8; ++c) {
        float4 x = *(const float4*)(vp + c * 4);
        bfraw* d = sVt + (hf * 8 + c) * 136 + key;
        d[0] = (bfraw)f2bf(x.x); d[16 * 136] = (bfraw)f2bf(x.y); d[32 * 136] = (bfraw)f2bf(x.z); d[48 * 136] = (bfraw)f2bf(x.w);
      }
    }
    __syncthreads();
    f32x4 s[8];
#pragma unroll
    for (int n = 0; n < 8; ++n) {
      f32x4 acc = (f32x4){0.f, 0.f, 0.f, 0.f};
#pragma unroll
      for (int ks = 0; ks < 2; ++ks) {
        bf16x8 kf = *(const bf16x8*)(sK + (n * 16 + fr) * 128 + (((ks * 4 + fq) ^ sw) << 4));
        acc = mfma16(qf[ks], kf, acc);
      }
      s[n] = acc;
    }
#pragma unroll
    for (int n = 0; n < 8; ++n)
#pragma unroll
      for (int j = 0; j < 4; ++j) {
        float v = s[n][j] * 0.125f;
        if (local) {
          const int qc = wid * 16 + fq * 4 + j;
          const int kidx = n * 16 + fr;
          const int krow = krow0 + (kidx >> 6), kc = kidx & 63;
          const int cs = min(max(qc - 8, 0), 48);
          const bool ok = (kc >= cs) && (kc < cs + 16);
          const int dr = krow - r + 7;
          const int dc = min(max(kc - qc + 15, 0), 30);
          const float bias = sRpb[dr * 31 + dc];
          v = ok ? v + bias : -1e30f;
        }
        s[n][j] = v;
      }
#pragma unroll
    for (int j = 0; j < 4; ++j) {
      float mx = s[0][j];
#pragma unroll
      for (int n = 1; n < 8; ++n) mx = fmaxf(mx, s[n][j]);
      mx = max16(mx);
      const float mn = fmaxf(m_run[j], mx);
      const float alpha = __expf(m_run[j] - mn);
      float sum = 0.f;
#pragma unroll
      for (int n = 0; n < 8; ++n) { float pv = __expf(s[n][j] - mn); s[n][j] = pv; sum += pv; }
      sum = sum16(sum);
      l_run[j] = l_run[j] * alpha + sum;
      m_run[j] = mn;
#pragma unroll
      for (int n = 0; n < 4; ++n) o[n][j] *= alpha;
    }
#pragma unroll
    for (int n = 0; n < 8; ++n)
#pragma unroll
      for (int j = 0; j < 4; ++j) sP[(wid * 16 + fq * 4 + j) * 136 + n * 16 + fr] = (bfraw)f2bf(s[n][j]);
    __syncthreads();
#pragma unroll
    for (int ks = 0; ks < 4; ++ks) {
      bf16x8 pf = *(const bf16x8*)(sP + (wid * 16 + fr) * 136 + ks * 32 + fq * 8);
#pragma unroll
      for (int n = 0; n < 4; ++n) {
        bf16x8 vf = *(const bf16x8*)(sVt + (n * 16 + fr) * 136 + ks * 32 + fq * 8);
        o[n] = mfma16(pf, vf, o[n]);
      }
    }
  }
#pragma unroll
  for (int j = 0; j < 4; ++j) {
    const float inv = 1.f / l_run[j];
    uint2 ov; ov.x = pack2(o[0][j] * inv, o[1][j] * inv); ov.y = pack2(o[2][j] * inv, o[3][j] * inv);
    *(uint2*)(p.O + (size_t)(qtok0 + wid * 16 + fq * 4 + j) * D + h * 64 + 4 * fr) = ov;
  }
}

__device__ void sgu_unit(const P& p, int l, int unit, char* smem) {
  const int tid = otid(), lane = tid & 63, wid = tid >> 6;
  const int fr = lane & 15, fq = lane >> 4;
  const int g = unit & 3, chunk = unit >> 2;
  const int tok0 = chunk * 128;
  char* sA = smem;
  bfraw* sVn = (bfraw*)(smem + 32768);
  float* sStat = (float*)(smem + 32768 + 17408);
  __syncthreads();
  {
    const int q = tid >> 1, hf = tid & 1;
    const float* vp = p.Z + (size_t)(tok0 + q) * DIN + 1792 + hf * 128;
    float s1 = 0.f, s2 = 0.f;
#pragma unroll 8
    for (int i = 0; i < 32; ++i) {
      float4 x = *(const float4*)(vp + i * 4);
      s1 += (x.x + x.y) + (x.z + x.w);
      s2 += (x.x * x.x + x.y * x.y) + (x.z * x.z + x.w * x.w);
    }
    s1 += dpp<0xB1>(s1); s2 += dpp<0xB1>(s2);
    const float mu = s1 * (1.f / 256.f);
    const float var = fmaxf(s2 * (1.f / 256.f) - mu * mu, 0.f);
    const float rstd = rsqrtf(var + EPS);
    const float* gp = p.Z + (size_t)(tok0 + q) * DIN + 1792 + g * 64 + hf * 32;
    const float* lw = p.sgu_ln_w + l * 256 + g * 64 + hf * 32;
    const float* lb = p.sgu_ln_b + l * 256 + g * 64 + hf * 32;
#pragma unroll
    for (int c = 0; c < 8; ++c) {
      float4 x = *(const float4*)(gp + c * 4), w = *(const float4*)(lw + c * 4), bb = *(const float4*)(lb + c * 4);
      bfraw* d = sVn + (hf * 8 + c) * 136 + q;
      d[0] = (bfraw)f2bf((x.x - mu) * rstd * w.x + bb.x);
      d[16 * 136] = (bfraw)f2bf((x.y - mu) * rstd * w.y + bb.y);
      d[32 * 136] = (bfraw)f2bf((x.z - mu) * rstd * w.z + bb.z);
      d[48 * 136] = (bfraw)f2bf((x.w - mu) * rstd * w.w + bb.w);
    }
    const float* wsrc = p.sgu_w_s + (size_t)(l * 4 + g) * 128 * 128;
    const int prow = tid >> 1;
#pragma unroll
    for (int c = 0; c < 8; ++c) {
      const int chunkc = hf * 8 + c;
      float4 x0 = *(const float4*)(wsrc + prow * 128 + chunkc * 8), x1 = *(const float4*)(wsrc + prow * 128 + chunkc * 8 + 4);
      *(uint4*)(sA + prow * 256 + ((chunkc ^ (prow & 15)) << 4)) = pack8(x0, x1);
    }
    (void)sStat;
  }
  __syncthreads();
  f32x4 acc[2][4];
#pragma unroll
  for (int m = 0; m < 2; ++m)
#pragma unroll
    for (int n = 0; n < 4; ++n) acc[m][n] = (f32x4){0.f, 0.f, 0.f, 0.f};
#pragma unroll
  for (int ks = 0; ks < 4; ++ks) {
    bf16x8 af[2], bf[4];
#pragma unroll
    for (int m = 0; m < 2; ++m) {
      const int row = wid * 32 + m * 16 + fr;
      af[m] = *(const bf16x8*)(sA + row * 256 + (((ks * 4 + fq) ^ (row & 15)) << 4));
    }
#pragma unroll
    for (int n = 0; n < 4; ++n) bf[n] = *(const bf16x8*)(sVn + (n * 16 + fr) * 136 + ks * 32 + fq * 8);
#pragma unroll
    for (int m = 0; m < 2; ++m)
#pragma unroll
      for (int n = 0; n < 4; ++n) acc[m][n] = mfma16(af[m], bf[n], acc[m][n]);
  }
#pragma unroll
  for (int m = 0; m < 2; ++m)
#pragma unroll
    for (int j = 0; j < 4; ++j) {
      const int pr = wid * 32 + m * 16 + fq * 4 + j;
      const float bs = p.sgu_b_s[(l * 4 + g) * 128 + pr];
      const float4 u = *(const float4*)(p.Z + (size_t)(tok0 + pr) * DIN + 1536 + g * 64 + 4 * fr);
      uint2 ov; ov.x = pack2(u.x * (acc[m][0][j] + bs), u.y * (acc[m][1][j] + bs));
      ov.y = pack2(u.z * (acc[m][2][j] + bs), u.w * (acc[m][3][j] + bs));
      *(uint2*)(p.O + (size_t)(tok0 + pr) * D + 512 + g * 64 + 4 * fr) = ov;
    }
}

__device__ void phase_mixer(const P& p, int l, char* smem, int* s_item, int rep) {
  const int nitems = 576 + 256 + 1024 + 320 + ((l == 0 && rep == 0) ? N_LATE_T : 0);
  unsigned* ctr = p.bar + XCD_BAR_WORDS + 16 * l + 4 * rep;
  for (;;) {
    __syncthreads();
    if (otid() == 0) *s_item = (int)atomicAdd(ctr, 1u);
    __syncthreads();
    const int i = *s_item;
    if (i >= nitems) break;
    if (i < 64) scan_item(p, l, i, smem);
    else if (i < 576) scan_item8(p, l, i - 64, smem);
    else if (i < 832) attn_unit(p, l, 1024 + (i - 576), smem);
    else if (i < 1856) attn_unit(p, l, i - 832, smem);
    else if (i < 2176) sgu_unit(p, l, i - 1856, smem);
    else transpose_item(p, late_transpose_id(i - 2176), smem);
  }
}

__device__ void phase_post(const P& p, int l) {
  constexpr int NT = 4;
  const int lane = otid() & 63;
  const int gw = (obid() * 256 + otid()) >> 6, nw = gridDim.x * 4;
  const int c = lane * 4;
  const float4 lnw = *(const float4*)(p.ln_w + l * 256 + c);
  const float4 lnb = *(const float4*)(p.ln_b + l * 256 + c);
  const float4 rkw = *(const float4*)(p.r_k + l * 256 + c);
  const float* g2p = p.g2 + (size_t)l * 64 * 256 + c;
  for (int tok0 = gw * NT; tok0 < NTOK; tok0 += nw * NT) {
    float sg[NT];
    float4 g[NT];
#pragma unroll
    for (int t = 0; t < NT; ++t) {
      sg[t] = sigmoidf_(p.Z[(size_t)(tok0 + t) * DIN + 2944 + lane]);
      g[t] = make_float4(0.f, 0.f, 0.f, 0.f);
    }
#pragma unroll 4
    for (int r = 0; r < 64; ++r) {
      const float4 w = *(const float4*)(g2p + r * 256);
#pragma unroll
      for (int t = 0; t < NT; ++t) {
        const float sv = bcast(sg[t], r);
        g[t].x += sv * w.x; g[t].y += sv * w.y; g[t].z += sv * w.z; g[t].w += sv * w.w;
      }
    }
#pragma unroll
    for (int t = 0; t < NT; ++t) {
      const int tok = tok0 + t;
      const float* z = p.Z + (size_t)tok * DIN;
      const float4 yf = *(const float4*)(p.Y + (size_t)tok * 256 + c);
      const float4 yb = *(const float4*)(p.Y + (size_t)(NTOK + tok) * 256 + c);
      float4 y = make_float4(yf.x + yb.x, yf.y + yb.y, yf.z + yb.z, yf.w + yb.w);
      const float s1 = sum16((y.x + y.y) + (y.z + y.w));
      const float mu = s1 * (1.f / 64.f);
      y.x -= mu; y.y -= mu; y.z -= mu; y.w -= mu;
      const float s2 = sum16((y.x * y.x + y.y * y.y) + (y.z * y.z + y.w * y.w));
      const float rstd = rsqrtf(s2 * (1.f / 64.f) + GN_EPS);
      const float4 r4 = *(const float4*)(z + 2048 + c);
      const float4 k4 = *(const float4*)(z + 2304 + c);
      const float4 v4 = *(const float4*)(z + 2560 + c);
      const float rk = sum16((r4.x * k4.x * rkw.x + r4.y * k4.y * rkw.y) + (r4.z * k4.z * rkw.z + r4.w * k4.w * rkw.w));
      const float o0 = (y.x * rstd * lnw.x + lnb.x + rk * v4.x) * g[t].x;
      const float o1 = (y.y * rstd * lnw.y + lnb.y + rk * v4.y) * g[t].y;
      const float o2 = (y.z * rstd * lnw.z + lnb.z + rk * v4.z) * g[t].z;
      const float o3 = (y.w * rstd * lnw.w + lnb.w + rk * v4.w) * g[t].w;
      uint2 ov; ov.x = pack2(o0, o1); ov.y = pack2(o2, o3);
      *(uint2*)(p.O + (size_t)tok * D + 768 + c) = ov;
    }
  }
}

constexpr int NPHASE = 26;

__global__ void __launch_bounds__(256, 3) mk(P p, int ph_lo, int ph_hi) {
  __shared__ __attribute__((aligned(16))) char smem[53248];
  __shared__ uint4 xb_words;
  __shared__ int s_item;
  cg::grid_group grid = cg::this_grid();
  if (ph_hi < 0) grid.sync();
  if (threadIdx.x == 0) xb_words = make_uint4(0u, 0u, 0u, 0u);
  __syncthreads();
  XcdBarrier xb;
  xb.bar = p.bar; xb.x = 0; xb.st = (volatile LAS unsigned*)&xb_words;
  if (ph_hi - ph_lo > 1) xb = xcd_barrier_post(p.bar, (volatile LAS unsigned*)&xb_words);
#define RUN(idx, ...)                                   \
  if (ph_lo <= (idx) && (idx) < ph_hi) {                \
    __VA_ARGS__;                                        \
    if ((idx) + 1 < ph_hi) xcd_barrier(xb);             \
  }
#define RUNS(slot, idx, ...)                                                  \
  if (ph_lo <= (idx) && (idx) < ph_hi) {                                      \
    const int nrep = 1 + (((REPMASK) >> (slot)) & 1);                         \
    for (int rep = 0; rep < nrep; ++rep) {                                    \
      __VA_ARGS__;                                                            \
      if (rep + 1 < nrep || (idx) + 1 < ph_hi) xcd_barrier(xb);               \
    }                                                                         \
  }
  RUN(0, phase_prologue(p, smem, &s_item))
  RUN(1, phase_rowop(p, 0, -1, 0, 0))
  for (int l = 0; l < 2; ++l) {
    const int pb = 2 + 12 * l;
    RUNS(0, pb + 0, phase_gemm<EPI_SWIGLU>(p, p.H, p.wt_gu + (size_t)(l * 2 + 0) * 5632 * 1024, 1024, 44, l, smem))
#if PROBE_MODE
    if (l == 0 && ph_hi - ph_lo > 1) { phase_gemm<EPI_SWIGLU, PROBE_MODE>(p, p.H, p.wt_gu, 1024, 44, l, smem); xcd_barrier(xb); }
#endif
    RUNS(1, pb + 1, phase_gemm_n1024(p, p.ACT, p.wt_down + (size_t)(l * 2 + 0) * 1024 * 2816, 2816, l, smem))
    RUN(pb + 2, phase_rowop(p, l, 0, l, 1))
    RUNS(3, pb + 3, phase_gemm<EPI_Z>(p, p.H, p.wt_in + (size_t)l * DINP * 1024, 1024, 24, l, smem))
    RUNS(4, pb + 4, phase_prep(p, l))
    RUNS(5, pb + 5, phase_mixer(p, l, smem, &s_item, rep))
    RUNS(6, pb + 6, phase_post(p, l))
    RUNS(7, pb + 7, phase_gemm_n1024(p, p.O, p.wt_out + (size_t)l * 1024 * 1024, 1024, l, smem))
    RUN(pb + 8, phase_rowop(p, l, 1, l, 2))
    RUNS(9, pb + 9, phase_gemm<EPI_SWIGLU>(p, p.H, p.wt_gu + (size_t)(l * 2 + 1) * 5632 * 1024, 1024, 44, l, smem))
    RUNS(10, pb + 10, phase_gemm_n1024(p, p.ACT, p.wt_down + (size_t)(l * 2 + 1) * 1024 * 2816, 2816, l, smem))
    RUN(pb + 11, phase_rowop(p, l, 2, l + 1, (l + 1 < 2) ? 0 : -1))
  }
#undef RUN
#undef RUNS
}

extern "C" void kernel_launch(void* const* d_in, const int* in_sizes, int n_in, void* d_out, int out_size, void* d_ws,
                              size_t ws_size, hipStream_t stream) {
  static int grid_blocks = 0;
  if (!grid_blocks) {
    int dev = 0, cus = 0, per_cu = 0;
    hipGetDevice(&dev);
    hipDeviceGetAttribute(&cus, hipDeviceAttributeMultiprocessorCount, dev);
    hipOccupancyMaxActiveBlocksPerMultiprocessor(&per_cu, mk, 256, 0);
    if (per_cu > 3) per_cu = 3;
    if (per_cu < 1) per_cu = 1;
    grid_blocks = cus * per_cu;
  }
  P p{};
  const float* const* in = (const float* const*)d_in;
  p.x_prompt = in[0]; p.x_sample = in[1]; p.cache_k = in[2]; p.cache_v = in[3]; p.state = in[4]; p.c = in[5];
  p.c_ctx = in[6]; p.w_ada = in[7]; p.b_ada = in[8]; p.norm_pre = in[9]; p.norm_post = in[10]; p.w_gu = in[11];
  p.w_down = in[12]; p.w_in = in[13]; p.w_out = in[14]; p.rpb = in[15]; p.sgu_ln_w = in[16]; p.sgu_ln_b = in[17];
  p.sgu_w_s = in[18]; p.sgu_b_s = in[19]; p.w0 = in[20]; p.w2 = in[21]; p.a0 = in[22]; p.a2 = in[23]; p.g2 = in[24];
  p.k_k = in[25]; p.k_a = in[26]; p.r_k = in[27]; p.ln_w = in[28]; p.ln_b = in[29];
  float* out = (float*)d_out;
  p.X = out;
  p.out_k = out + (size_t)NTOK * D;
  p.out_v = p.out_k + (size_t)32 * 2 * 256 * 512;
  p.out_state = p.out_v + (size_t)32 * 2 * 256 * 512;
  char* ws = (char*)d_ws;
  size_t off = 0;
  auto take = [&](size_t bytes) { char* r = ws + off; off += (bytes + 255) & ~(size_t)255; return r; };
  p.wt_gu = (bfraw*)take((size_t)4 * 5632 * 1024 * 2);
  p.wt_down = (bfraw*)take((size_t)4 * 1024 * 2816 * 2);
  p.wt_in = (bfraw*)take((size_t)2 * DINP * 1024 * 2);
  p.wt_out = (bfraw*)take((size_t)2 * 1024 * 1024 * 2);
  p.mods = (float*)take((size_t)2 * 3 * 9216 * 4);
  char* hy = take((size_t)NTOK * D * 2);
  p.H = (bfraw*)hy; p.Y = (float*)hy;
  char* u = take((size_t)NTOK * DIN * 4);
  p.Z = (float*)u; p.ACT = (bfraw*)u; p.F = (float*)(u + ((size_t)64 << 20));
  p.O = (bfraw*)take((size_t)NTOK * D * 2);
  p.PREP = (float*)take((size_t)NTOK * NPREP * 4);
  p.XB = (bfraw*)take((size_t)NTOK * D * 2);
  p.QB = (bfraw*)take((size_t)NTOK * 512 * 2);
  p.bar = (unsigned*)take((size_t)(XCD_BAR_WORDS + 64) * 4);
  if (off > ws_size) { fprintf(stderr, "workspace too small: need %zu have %zu\n", off, ws_size); return; }
  hipMemsetAsync(p.bar, 0, (size_t)(XCD_BAR_WORDS + 64) * 4, stream);
#if COOP
  int lo = 0, hi = NPHASE;
  void* args[] = {&p, &lo, &hi};
  hipError_t e = hipLaunchCooperativeKernel((void*)mk, dim3(grid_blocks), dim3(256), args, 0, stream);
  if (e != hipSuccess) fprintf(stderr, "cooperative launch failed: %s (grid %d)\n", hipGetErrorString(e), grid_blocks);
#else
  for (int ph = 0; ph < NPHASE; ++ph) mk<<<dim3(grid_blocks), dim3(256), 0, stream>>>(p, ph, ph + 1);
#endif
}
```

```cpp
#include <hip/hip_runtime.h>
#include <hip/hip_cooperative_groups.h>
#include <cstdio>
namespace cg = cooperative_groups;

#ifndef REPMASK
#define REPMASK 0x0
#endif
#ifndef PROBE_MODE
#define PROBE_MODE 0
#endif
#ifndef MIXREP
#define MIXREP 0
#endif
#ifndef COOP
#define COOP 1
#endif

typedef unsigned short bfraw;
typedef __attribute__((ext_vector_type(8))) short bf16x8;
typedef __attribute__((ext_vector_type(4))) float f32x4;
typedef __attribute__((ext_vector_type(2))) float f32x2;

constexpr int D = 1024, NTOK = 10240, NCTX = 8192, DFF = 2816, DIN = 3008, DINP = 3072;
constexpr int NPREP = 1280;
constexpr float EPS = 1e-6f, GN_EPS = 64e-5f;

struct P {
  const float *x_prompt, *x_sample, *cache_k, *cache_v, *state, *c, *c_ctx, *w_ada, *b_ada, *norm_pre, *norm_post,
      *w_gu, *w_down, *w_in, *w_out, *rpb, *sgu_ln_w, *sgu_ln_b, *sgu_w_s, *sgu_b_s, *w0, *w2, *a0, *a2, *g2, *k_k,
      *k_a, *r_k, *ln_w, *ln_b;
  float *X, *out_k, *out_v, *out_state;
  bfraw *wt_gu, *wt_down, *wt_in, *wt_out;
  float* mods;
  bfraw* H;
  float* Y;
  float* Z;
  bfraw* ACT;
  float* F;
  bfraw* O;
  float* PREP;
  unsigned* bar;
  bfraw* XB;
  bfraw* QB;
  bfraw* UB;
};

__device__ __forceinline__ int otid() { int t = threadIdx.x; asm volatile("" : "+v"(t)); return t; }
__device__ __forceinline__ int obid() { int b = blockIdx.x; asm volatile("" : "+s"(b)); return b; }
__device__ __forceinline__ unsigned f2bf(float f) {
  unsigned u = __float_as_uint(f);
  u += 0x7fffu + ((u >> 16) & 1u);
  return u >> 16;
}
__device__ __forceinline__ unsigned pack2(float a, float b) { return f2bf(a) | (f2bf(b) << 16); }
__device__ __forceinline__ uint4 pack8(float4 a, float4 b) {
  uint4 r;
  r.x = pack2(a.x, a.y); r.y = pack2(a.z, a.w); r.z = pack2(b.x, b.y); r.w = pack2(b.z, b.w);
  return r;
}
__device__ __forceinline__ float sigmoidf_(float x) { return 1.f / (1.f + __expf(-x)); }

template <int CTRL>
__device__ __forceinline__ float dpp(float x) {
  return __int_as_float(__builtin_amdgcn_update_dpp(0, __float_as_int(x), CTRL, 0xF, 0xF, true));
}
__device__ __forceinline__ float sum8(float x) {
  x += dpp<0xB1>(x); x += dpp<0x4E>(x); x += dpp<0x141>(x);
  return x;
}
__device__ __forceinline__ float sum16(float x) {
  x += dpp<0xB1>(x); x += dpp<0x4E>(x); x += dpp<0x141>(x); x += dpp<0x140>(x);
  return x;
}
__device__ __forceinline__ float max16(float x) {
  x = fmaxf(x, dpp<0xB1>(x)); x = fmaxf(x, dpp<0x4E>(x)); x = fmaxf(x, dpp<0x141>(x)); x = fmaxf(x, dpp<0x140>(x));
  return x;
}
__device__ __forceinline__ float sum64(float x) {
#pragma unroll
  for (int o = 32; o > 0; o >>= 1) x += __shfl_xor(x, o);
  return x;
}
__device__ __forceinline__ float bcast(float x, int srclane) {
  return __int_as_float(__builtin_amdgcn_readlane(__float_as_int(x), srclane));
}
__device__ __forceinline__ f32x4 mfma16(bf16x8 a, bf16x8 b, f32x4 c) {
  return __builtin_amdgcn_mfma_f32_16x16x32_bf16(a, b, c, 0, 0, 0);
}
__device__ __forceinline__ bf16x8 as_bf8(uint4 v) {
  union { uint4 u; bf16x8 b; } x; x.u = v; return x.b;
}

#define XB_TMO 128
#define XB_XCNT(j) (256 + 64 * (j))
#define XB_XSUB(j) (1280 + 64 * (j))
#define XB_XGEN(j) (2304 + 64 * (j))
#define XB_TOP 3328
#define XB_TOPGEN 3392
#define XCD_BAR_WORDS 3456
#define XB_SPIN_CAP (1u << 22)
#define LAS __attribute__((address_space(3)))
__device__ __forceinline__ unsigned xb_ld(unsigned* p) { return __hip_atomic_load(p, __ATOMIC_RELAXED, __HIP_MEMORY_SCOPE_AGENT); }
__device__ __forceinline__ unsigned xb_add(unsigned* p, unsigned v) { return __hip_atomic_fetch_add(p, v, __ATOMIC_RELAXED, __HIP_MEMORY_SCOPE_AGENT); }
__device__ __forceinline__ unsigned xb_xcc_id() { return (unsigned)__builtin_amdgcn_s_getreg((3 << 11) | 20) & 0xFu; }
#define XB_SPIN(cond, bar) do { unsigned _sp = 0; while (cond) { __builtin_amdgcn_s_sleep(1); \
    if ((++_sp & 255u) == 0u) { if (xb_ld(&(bar)[XB_TMO])) break; if (_sp > XB_SPIN_CAP) { atomicAdd(&(bar)[XB_TMO], 1u); break; } } } } while (0)
struct XcdBarrier { unsigned* bar; unsigned x; volatile LAS unsigned* st; };
__device__ __forceinline__ XcdBarrier xcd_barrier_post(unsigned* bar, volatile LAS unsigned* st) {
  XcdBarrier b; b.bar = bar; b.x = xb_xcc_id(); b.st = st;
  if (threadIdx.x == 0) (void)xb_add(&bar[XB_XCNT(b.x)], 1u);
  return b;
}
__device__ __forceinline__ void xcd_barrier_complete(unsigned* bar, unsigned x, unsigned& nloc, unsigned& nx) {
  const unsigned G = gridDim.x * gridDim.y * gridDim.z;
  unsigned sum, cnt, mine, sp = 0u;
  for (;;) {
    sum = 0u; cnt = 0u; mine = 0u;
#pragma unroll
    for (unsigned j = 0; j < 16; ++j) { const unsigned c = xb_ld(&bar[XB_XCNT(j)]); sum += c; cnt += (c > 0u) ? 1u : 0u; mine = (j == x) ? c : mine; }
    if (sum == G) break;
    __builtin_amdgcn_s_sleep(1);
    if ((++sp & 255u) == 0u) { if (xb_ld(&bar[XB_TMO])) break; if (sp > XB_SPIN_CAP) { atomicAdd(&bar[XB_TMO], 1u); break; } }
  }
  nloc = mine > 0u ? mine : 1u; nx = cnt > 0u ? cnt : 1u;
}
__device__ __forceinline__ void xcd_barrier(const XcdBarrier& b) {
  asm volatile("s_waitcnt vmcnt(0)" ::: "memory");
  __syncthreads();
  if (threadIdx.x == 0) {
    unsigned* bar = b.bar;
    __builtin_amdgcn_s_waitcnt(0);
    unsigned nloc = b.st[0], nx = b.st[1];
    if (nloc == 0u) { xcd_barrier_complete(bar, b.x, nloc, nx); b.st[0] = nloc; b.st[1] = nx; }
    const unsigned old = xb_add(&bar[XB_XSUB(b.x)], 1u);
    const unsigned gen = old / nloc;
    if (old + 1u == (gen + 1u) * nloc) {
      __builtin_amdgcn_fence(__ATOMIC_RELEASE, "agent");
      asm volatile("s_waitcnt vmcnt(0)" ::: "memory");
      const unsigned og = xb_add(&bar[XB_TOP], 1u);
      const unsigned tg = og / nx;
      if (og + 1u == (tg + 1u) * nx) xb_add(&bar[XB_TOPGEN], 1u);
      else XB_SPIN(xb_ld(&bar[XB_TOPGEN]) == tg, bar);
      __builtin_amdgcn_fence(__ATOMIC_ACQUIRE, "agent");
      xb_add(&bar[XB_XGEN(b.x)], 1u);
      asm volatile("s_waitcnt vmcnt(0)" ::: "memory");
    } else {
      XB_SPIN(xb_ld(&bar[XB_XGEN(b.x)]) == gen, bar);
      __builtin_amdgcn_fence(__ATOMIC_ACQUIRE, "agent");
      asm volatile("s_waitcnt vmcnt(0)" ::: "memory");
    }
  }
  __syncthreads();
}

__device__ void transpose_item(const P& p, int i, char* smem) {
  const float* src; bfraw* dst; int K, N, tiles_n, t;
  if (i < 5632) { int m = i / 1408; t = i % 1408; K = 1024; N = 5632; tiles_n = 88;
    src = p.w_gu + (size_t)m * 1024 * 5632; dst = p.wt_gu + (size_t)m * 5632 * 1024; }
  else if (i < 8448) { int j = i - 5632; int m = j / 704; t = j % 704; K = 2816; N = 1024; tiles_n = 16;
    src = p.w_down + (size_t)m * 2816 * 1024; dst = p.wt_down + (size_t)m * 1024 * 2816; }
  else if (i < 9984) { int j = i - 8448; int m = j / 768; t = j % 768; K = 1024; N = 3008; tiles_n = 48;
    src = p.w_in + (size_t)m * 1024 * 3008; dst = p.wt_in + (size_t)m * DINP * 1024; }
  else { int j = i - 9984; int m = j / 256; t = j % 256; K = 1024; N = 1024; tiles_n = 16;
    src = p.w_out + (size_t)m * 1024 * 1024; dst = p.wt_out + (size_t)m * 1024 * 1024; }
  const int k0 = (t / tiles_n) * 64, n0 = (t % tiles_n) * 64;
  float* tile = (float*)smem;
  const int tid = otid();
#pragma unroll
  for (int ii = 0; ii < 4; ++ii) {
    int kk = (tid >> 4) + 16 * ii, n4 = (tid & 15) * 4, n = n0 + n4;
    float4 v = make_float4(0.f, 0.f, 0.f, 0.f);
    if (n < N) {
      const f32x4 t4 = __builtin_nontemporal_load((const f32x4*)(src + (size_t)(k0 + kk) * N + n));
      v = make_float4(t4[0], t4[1], t4[2], t4[3]);
    }
    float* tp = tile + kk * 65 + n4;
    tp[0] = v.x; tp[1] = v.y; tp[2] = v.z; tp[3] = v.w;
  }
  __syncthreads();
  {
    int n = tid >> 2, ks = (tid & 3) * 16;
    float v[16];
#pragma unroll
    for (int j = 0; j < 16; ++j) v[j] = tile[(ks + j) * 65 + n];
    uint4 a, b;
    a.x = pack2(v[0], v[1]); a.y = pack2(v[2], v[3]); a.z = pack2(v[4], v[5]); a.w = pack2(v[6], v[7]);
    b.x = pack2(v[8], v[9]); b.y = pack2(v[10], v[11]); b.z = pack2(v[12], v[13]); b.w = pack2(v[14], v[15]);
    bfraw* dp = dst + (size_t)(n0 + n) * K + k0 + ks;
    *(uint4*)dp = a; *(uint4*)(dp + 8) = b;
  }
  __syncthreads();
}

__device__ void adaln_item(const P& p, int j, char* smem) {
  const int l = j / 144, n0 = (j % 144) * 64, tid = otid();
  float* sc = (float*)smem;
  float* red = sc + 3072;
  for (int idx = tid; idx < 3072; idx += 256) {
    int b = idx >> 10, k = idx & 1023;
    float cv = (b == 0) ? p.c_ctx[k] : p.c[(b - 1) * 1024 + k];
    sc[idx] = cv / (1.f + __expf(-cv));
  }
  __syncthreads();
  const int kq = tid >> 4, c4 = tid & 15;
  float acc[3][4];
#pragma unroll
  for (int b = 0; b < 3; ++b)
#pragma unroll
    for (int e = 0; e < 4; ++e) acc[b][e] = 0.f;
  const float* wp = p.w_ada + (size_t)l * 1024 * 9216 + n0 + c4 * 4;
#pragma unroll 16
  for (int i = 0; i < 64; ++i) {
    int k = kq + 16 * i;
    const f32x4 w4 = __builtin_nontemporal_load((const f32x4*)(wp + (size_t)k * 9216));
    const float4 w = make_float4(w4[0], w4[1], w4[2], w4[3]);
#pragma unroll
    for (int b = 0; b < 3; ++b) {
      float s = sc[b * 1024 + k];
      acc[b][0] += s * w.x; acc[b][1] += s * w.y; acc[b][2] += s * w.z; acc[b][3] += s * w.w;
    }
  }
#pragma unroll
  for (int b = 0; b < 3; ++b)
#pragma unroll
    for (int e = 0; e < 4; ++e) red[(kq * 3 + b) * 64 + c4 * 4 + e] = acc[b][e];
  __syncthreads();
  if (tid < 192) {
    int b = tid >> 6, col = tid & 63;
    float s = 0.f;
#pragma unroll
    for (int q = 0; q < 16; ++q) s += red[(q * 3 + b) * 64 + col];
    const int n = n0 + col, idx = n >> 10, c = n & 1023, sub = idx / 3, kind = idx - 3 * sub;
    float v = s + p.b_ada[l * 9216 + n];
    if (kind == 1) v = p.norm_pre[(size_t)(l * 3 + sub) * 1024 + c] * (1.f + v);
    else if (kind == 2) v = ((sub == 1) ? 1.f : 0.5f) * v * p.norm_post[(size_t)(l * 3 + sub) * 1024 + c];
    p.mods[(size_t)(l * 3 + b) * 9216 + n] = v;
  }
  __syncthreads();
}

__device__ __forceinline__ int early_transpose_id(int e) {
  return e < 1408 ? e : (e < 2112 ? 5632 + (e - 1408) : 8448 + (e - 2112));
}
__device__ __forceinline__ int late_transpose_id(int k) {
  return k < 4224 ? 1408 + k : (k < 6336 ? 6336 + (k - 4224) : (k < 7104 ? 9216 + (k - 6336) : 9984 + (k - 7104)));
}
constexpr int N_EARLY_T = 2880, N_LATE_T = 7616;

__device__ void phase_prologue(const P& p, char* smem, int* s_item) {
  const int nitems = 288 + N_EARLY_T;
  unsigned* ctr = p.bar + XCD_BAR_WORDS + 40;
  for (;;) {
    __syncthreads();
    if (otid() == 0) *s_item = (int)atomicAdd(ctr, 1u);
    __syncthreads();
    const int i = *s_item;
    if (i >= nitems) break;
    if (i < 288) adaln_item(p, i, smem);
    else transpose_item(p, early_transpose_id(i - 288), smem);
  }
}

__device__ __forceinline__ void unpack8(const uint4 u, float4& a, float4& b) {
  a = make_float4(__uint_as_float(u.x << 16), __uint_as_float(u.x & 0xffff0000u), __uint_as_float(u.y << 16), __uint_as_float(u.y & 0xffff0000u));
  b = make_float4(__uint_as_float(u.z << 16), __uint_as_float(u.z & 0xffff0000u), __uint_as_float(u.w << 16), __uint_as_float(u.w & 0xffff0000u));
}
__device__ void phase_rowop(const P& p, int l_post, int i_post, int l_next, int i_next) {
  const int lane = otid() & 63;
  const int gw = (obid() * 256 + otid()) >> 6, nw = gridDim.x * 4;
  for (int row = gw; row < NTOK; row += nw) {
    const int ms = row < NCTX ? 0 : 1 + ((row - NCTX) >> 10);
    float4 x[4];
    if (i_post < 0) {
      const float4* src = (const float4*)(row < NCTX ? p.x_prompt + (size_t)row * D : p.x_sample + (size_t)(row - NCTX) * D);
#pragma unroll
      for (int j = 0; j < 2; ++j) { x[2 * j] = src[j * 128 + lane * 2]; x[2 * j + 1] = src[j * 128 + lane * 2 + 1]; }
    } else {
      const uint4* xs = (const uint4*)(p.XB + (size_t)row * D);
      const uint4* fs = (const uint4*)((const bfraw*)p.F + (size_t)row * D);
      float4 f[4];
      float ss = 0.f;
#pragma unroll
      for (int j = 0; j < 2; ++j) {
        const uint4 xb = xs[j * 64 + lane], fb = fs[j * 64 + lane];
        unpack8(xb, x[2 * j], x[2 * j + 1]);
        unpack8(fb, f[2 * j], f[2 * j + 1]);
      }
#pragma unroll
      for (int j = 0; j < 4; ++j) ss += f[j].x * f[j].x + f[j].y * f[j].y + f[j].z * f[j].z + f[j].w * f[j].w;
      ss = sum64(ss);
      const float rstd = rsqrtf(ss * (1.f / 1024.f) + EPS);
      const float4* gt = (const float4*)(p.mods + (size_t)(l_post * 3 + ms) * 9216 + (3 * i_post + 2) * 1024);
#pragma unroll
      for (int j = 0; j < 4; ++j) {
        const float4 g = gt[(j >> 1) * 128 + lane * 2 + (j & 1)];
        x[j].x += g.x * (f[j].x * rstd);
        x[j].y += g.y * (f[j].y * rstd);
        x[j].z += g.z * (f[j].z * rstd);
        x[j].w += g.w * (f[j].w * rstd);
      }
    }
    if (i_next < 0) {
      float4* xd = (float4*)(p.X + (size_t)row * D);
#pragma unroll
      for (int j = 0; j < 4; ++j) xd[(j >> 1) * 128 + lane * 2 + (j & 1)] = x[j];
    } else {
      uint4* xd = (uint4*)(p.XB + (size_t)row * D);
#pragma unroll
      for (int j = 0; j < 2; ++j) xd[j * 64 + lane] = pack8(x[2 * j], x[2 * j + 1]);
    }
    if (i_next >= 0) {
      float ss = 0.f;
#pragma unroll
      for (int j = 0; j < 4; ++j) ss += x[j].x * x[j].x + x[j].y * x[j].y + x[j].z * x[j].z + x[j].w * x[j].w;
      ss = sum64(ss);
      const float rstd = rsqrtf(ss * (1.f / 1024.f) + EPS);
      const float4* sh = (const float4*)(p.mods + (size_t)(l_next * 3 + ms) * 9216 + (3 * i_next) * 1024);
      const float4* sc = (const float4*)(p.mods + (size_t)(l_next * 3 + ms) * 9216 + (3 * i_next + 1) * 1024);
      uint4* hd = (uint4*)(p.H + (size_t)row * D);
#pragma unroll
      for (int j = 0; j < 2; ++j) {
        float4 h[2];
#pragma unroll
        for (int e = 0; e < 2; ++e) {
          const int q = j * 128 + lane * 2 + e;
          const float4 s = sh[q], c = sc[q];
          const float4 xv = x[2 * j + e];
          h[e] = make_float4(xv.x * rstd * c.x + s.x, xv.y * rstd * c.y + s.y, xv.z * rstd * c.z + s.z, xv.w * rstd * c.w + s.w);
        }
        hd[j * 64 + lane] = pack8(h[0], h[1]);
      }
    }
  }
}

enum { EPI_SWIGLU = 0, EPI_F32 = 1, EPI_Z = 2 };

template <int EPI, int MODE = 0>
__device__ __forceinline__ void gemm_tile(const P& p, const bfraw* __restrict__ A, const bfraw* __restrict__ WT,
                                          int K, int tm, int tn, int l, char* smem) {
  const int tid = otid(), lane = tid & 63, wid = tid >> 6;
  const int fr = lane & 15, fq = lane >> 4;
  const int wr = wid >> 1, wc = wid & 1;
  char* sA = smem;
  char* sB = smem + 16384;
  const int lr = tid >> 3, lc = tid & 7;
  const bfraw* ap = A + (size_t)(tm * 128 + lr) * K + lc * 8;
  const bfraw* bp;
  size_t bstep;
  const int pcol = 8 * ((lr & 15) >> 2) + (lr & 3);
  size_t bo1, bo2, bo3;
  if (EPI == EPI_SWIGLU) {
    bp = WT + (size_t)((lr >> 4) * DFF + tn * 64 + pcol) * K + lc * 8;
    bo1 = (size_t)4 * K; bo2 = (size_t)32 * K; bo3 = (size_t)36 * K;
  } else {
    bp = WT + (size_t)(tn * 128 + pcol + 4 * (lr >> 4)) * K + lc * 8;
    bo1 = (size_t)32 * K; bo2 = (size_t)64 * K; bo3 = (size_t)96 * K;
  }
  bstep = 0; (void)bstep;
  const size_t astep = (size_t)32 * K;
  const int wofs = lr * 128 + ((lc ^ ((lr >> 1) & 7)) << 4);

  f32x4 acc[4][4];
#pragma unroll
  for (int m = 0; m < 4; ++m)
#pragma unroll
    for (int n = 0; n < 4; ++n) acc[m][n] = (f32x4){0.f, 0.f, 0.f, 0.f};

  uint4 ra0, ra1, ra2, ra3, rb0, rb1, rb2, rb3;
#define GLOAD(ko)                                                                                      \
  ra0 = *(const uint4*)(ap + (ko)); ra1 = *(const uint4*)(ap + astep + (ko));                          \
  ra2 = *(const uint4*)(ap + 2 * astep + (ko)); ra3 = *(const uint4*)(ap + 3 * astep + (ko));          \
  rb0 = *(const uint4*)(bp + (ko)); rb1 = *(const uint4*)(bp + bo1 + (ko));                            \
  rb2 = *(const uint4*)(bp + bo2 + (ko)); rb3 = *(const uint4*)(bp + bo3 + (ko));
  GLOAD(0)
  const int nkt = K >> 6;
  const int sw = (fr >> 1) & 7;
  for (int kt = 0; kt < nkt; ++kt) {
    __syncthreads();
    *(uint4*)(sA + wofs) = ra0; *(uint4*)(sA + wofs + 4096) = ra1;
    *(uint4*)(sA + wofs + 8192) = ra2; *(uint4*)(sA + wofs + 12288) = ra3;
    *(uint4*)(sB + wofs) = rb0; *(uint4*)(sB + wofs + 4096) = rb1;
    *(uint4*)(sB + wofs + 8192) = rb2; *(uint4*)(sB + wofs + 12288) = rb3;
    __syncthreads();
    if (MODE != 1 && kt + 1 < nkt) {
      const int ko = (kt + 1) * 64;
      GLOAD(ko)
    }
#pragma unroll
    for (int s2 = 0; s2 < 2; ++s2) {
      bf16x8 af[4], bf[4];
      const int co = ((s2 * 4 + fq) ^ sw) << 4;
#pragma unroll
      for (int m = 0; m < 4; ++m) af[m] = *(const bf16x8*)(sA + (wr * 64 + m * 16 + fr) * 128 + co);
#pragma unroll
      for (int n = 0; n < 4; ++n) bf[n] = *(const bf16x8*)(sB + (wc * 64 + n * 16 + fr) * 128 + co);
#pragma unroll
      for (int m = 0; m < 4; ++m)
#pragma unroll
        for (int n = 0; n < 4; ++n) {
          if (MODE == 2) { asm volatile("" ::"v"(af[m]), "v"(bf[n])); }
          else acc[m][n] = mfma16(bf[n], af[m], acc[m][n]);
        }
    }
  }
#undef GLOAD
  const int row0 = tm * 128 + wr * 64 + fr;
  if (EPI == EPI_SWIGLU) {
#pragma unroll
    for (int m = 0; m < 4; ++m) {
      float4 a[2];
#pragma unroll
      for (int q = 0; q < 2; ++q) {
        const f32x4 g = acc[m][2 * q], u = acc[m][2 * q + 1];
        a[q] = make_float4(g[0] * __builtin_amdgcn_rcpf(1.f + __expf(-g[0])) * u[0], g[1] * __builtin_amdgcn_rcpf(1.f + __expf(-g[1])) * u[1],
                           g[2] * __builtin_amdgcn_rcpf(1.f + __expf(-g[2])) * u[2], g[3] * __builtin_amdgcn_rcpf(1.f + __expf(-g[3])) * u[3]);
      }
      *(uint4*)((MODE ? (bfraw*)p.PREP : p.ACT) + (size_t)(row0 + m * 16) * DFF + tn * 64 + wc * 32 + fq * 8) = pack8(a[0], a[1]);
    }
  } else if (EPI == EPI_F32) {
#pragma unroll
    for (int m = 0; m < 4; ++m)
#pragma unroll
      for (int g2 = 0; g2 < 2; ++g2) {
        const f32x4 lo = acc[m][2 * g2], hi = acc[m][2 * g2 + 1];
        *(uint4*)((bfraw*)p.F + (size_t)(row0 + m * 16) * D + tn * 128 + wc * 64 + g2 * 32 + fq * 8) =
            pack8(make_float4(lo[0], lo[1], lo[2], lo[3]), make_float4(hi[0], hi[1], hi[2], hi[3]));
      }
  } else {
#pragma unroll
    for (int g2 = 0; g2 < 2; ++g2) {
      const int col = tn * 128 + wc * 64 + g2 * 32 + fq * 8;
      if (col < DIN) {
#pragma unroll
        for (int m = 0; m < 4; ++m) {
          const int row = row0 + m * 16;
          if (col < 512) {
            const f32x4 lo = acc[m][2 * g2], hi = acc[m][2 * g2 + 1];
            *(uint4*)(p.QB + (size_t)row * 512 + col) = pack8(make_float4(lo[0], lo[1], lo[2], lo[3]), make_float4(hi[0], hi[1], hi[2], hi[3]));
          } else if (col >= 1536 && col < 2048) {
            const f32x4 lo = acc[m][2 * g2], hi = acc[m][2 * g2 + 1];
            *(uint4*)(p.UB + (size_t)row * 512 + (col - 1536)) = pack8(make_float4(lo[0], lo[1], lo[2], lo[3]), make_float4(hi[0], hi[1], hi[2], hi[3]));
          } else if (row < NCTX && col >= 512 && col < 1536) {
            const int b = row >> 8, t = row & 255;
            float* dst = ((col < 1024) ? p.out_k : p.out_v) + ((size_t)(b * 2 + l) * 256 + t) * 512 + (col & 511);
            *(f32x4*)dst = acc[m][2 * g2]; *(f32x4*)(dst + 4) = acc[m][2 * g2 + 1];
          } else {
            float* zp = p.Z + (size_t)row * DIN + col;
            *(f32x4*)zp = acc[m][2 * g2]; *(f32x4*)(zp + 4) = acc[m][2 * g2 + 1];
          }
        }
      }
    }
  }
}

__device__ __forceinline__ void gemm_tile_half(const P& p, const bfraw* __restrict__ A, const bfraw* __restrict__ WT,
                                               int K, int tm, int tn, int nh, char* smem) {
  const int tid = otid(), lane = tid & 63, wid = tid >> 6;
  const int fr = lane & 15, fq = lane >> 4;
  const int wr = wid >> 1, wc = wid & 1;
  char* sA = smem;
  char* sB = smem + 16384;
  const int lr = tid >> 3, lc = tid & 7;
  const bfraw* ap = A + (size_t)(tm * 128 + lr) * K + lc * 8;
  const bfraw* bp = WT + (size_t)(tn * 128 + nh * 64 + 8 * ((lr & 15) >> 2) + 4 * (lr >> 4) + (lr & 3)) * K + lc * 8;
  const size_t astep = (size_t)32 * K;
  const int wofs = lr * 128 + ((lc ^ ((lr >> 1) & 7)) << 4);
  f32x4 acc[4][2];
#pragma unroll
  for (int m = 0; m < 4; ++m)
#pragma unroll
    for (int n = 0; n < 2; ++n) acc[m][n] = (f32x4){0.f, 0.f, 0.f, 0.f};
  uint4 ra0, ra1, ra2, ra3, rb0, rb1;
#define GLOADH(ko)                                                                                     \
  ra0 = *(const uint4*)(ap + (ko)); ra1 = *(const uint4*)(ap + astep + (ko));                          \
  ra2 = *(const uint4*)(ap + 2 * astep + (ko)); ra3 = *(const uint4*)(ap + 3 * astep + (ko));          \
  rb0 = *(const uint4*)(bp + (ko)); rb1 = *(const uint4*)(bp + astep + (ko));
  GLOADH(0)
  const int nkt = K >> 6;
  const int sw = (fr >> 1) & 7;
  for (int kt = 0; kt < nkt; ++kt) {
    __syncthreads();
    *(uint4*)(sA + wofs) = ra0; *(uint4*)(sA + wofs + 4096) = ra1;
    *(uint4*)(sA + wofs + 8192) = ra2; *(uint4*)(sA + wofs + 12288) = ra3;
    *(uint4*)(sB + wofs) = rb0; *(uint4*)(sB + wofs + 4096) = rb1;
    __syncthreads();
    if (kt + 1 < nkt) {
      const int ko = (kt + 1) * 64;
      GLOADH(ko)
    }
#pragma unroll
    for (int s2 = 0; s2 < 2; ++s2) {
      bf16x8 af[4], bf[2];
      const int co = ((s2 * 4 + fq) ^ sw) << 4;
#pragma unroll
      for (int m = 0; m < 4; ++m) af[m] = *(const bf16x8*)(sA + (wr * 64 + m * 16 + fr) * 128 + co);
#pragma unroll
      for (int n = 0; n < 2; ++n) bf[n] = *(const bf16x8*)(sB + (wc * 32 + n * 16 + fr) * 128 + co);
#pragma unroll
      for (int m = 0; m < 4; ++m)
#pragma unroll
        for (int n = 0; n < 2; ++n) acc[m][n] = mfma16(bf[n], af[m], acc[m][n]);
    }
  }
#undef GLOADH
  const int row0 = tm * 128 + wr * 64 + fr;
#pragma unroll
  for (int m = 0; m < 4; ++m) {
    const f32x4 lo = acc[m][0], hi = acc[m][1];
    *(uint4*)((bfraw*)p.F + (size_t)(row0 + m * 16) * D + tn * 128 + nh * 64 + wc * 32 + fq * 8) =
        pack8(make_float4(lo[0], lo[1], lo[2], lo[3]), make_float4(hi[0], hi[1], hi[2], hi[3]));
  }
}

__device__ void phase_gemm_n1024(const P& p, const bfraw* A, const bfraw* WT, int K, int l, char* smem) {
  const int bid = obid();
  const int x = bid & 7, j = bid >> 3;
  const int per = gridDim.x >> 3;
  if (per != 96) {
    const int id0 = (640 * x) >> 3, id1 = (640 * (x + 1)) >> 3;
    for (int id = id0 + j; id < id1; id += per) gemm_tile<EPI_F32, 0>(p, A, WT, K, (id >> 6) * 8 + (id & 7), (id & 63) >> 3, l, smem);
    return;
  }
  const int id0 = 80 * x;
  if (j < 64) {
    const int id = id0 + j;
    gemm_tile<EPI_F32, 0>(p, A, WT, K, (id >> 6) * 8 + (id & 7), (id & 63) >> 3, l, smem);
  } else {
    const int id = id0 + 64 + ((j - 64) >> 1);
    gemm_tile_half(p, A, WT, K, (id >> 6) * 8 + (id & 7), (id & 63) >> 3, (j - 64) & 1, smem);
  }
}

template <int EPI, int MODE = 0>
__device__ void phase_gemm(const P& p, const bfraw* A, const bfraw* WT, int K, int tiles_n, int l, char* smem) {
  const int bid = obid();
  const int x = bid & 7, j = bid >> 3;
  const int per = gridDim.x >> 3;
  const int ntiles = 80 * tiles_n;
  const int id0 = (ntiles * x) >> 3, id1 = (ntiles * (x + 1)) >> 3;
  const int group_sz = 8 * tiles_n;
  for (int id = id0 + j; id < id1; id += per) {
    const int g = id / group_sz, r = id - g * group_sz;
    gemm_tile<EPI, MODE>(p, A, WT, K, g * 8 + (r & 7), r >> 3, l, smem);
  }
}

__device__ void phase_prep(const P& p, int l) {
  constexpr int NT = 4;
  const int lane = otid() & 63;
  const int gw = (obid() * 256 + otid()) >> 6, nw = gridDim.x * 4;
  const int c = lane * 4;
  const float4 kkw = *(const float4*)(p.k_k + l * 256 + c);
  const float4 kaw = *(const float4*)(p.k_a + l * 256 + c);
  for (int tok0 = gw * NT; tok0 < NTOK; tok0 += nw * NT) {
    float4 k4[NT], kk[NT];
    float tw[NT], al[NT];
#pragma unroll
    for (int t = 0; t < NT; ++t) {
      const float* z = p.Z + (size_t)(tok0 + t) * DIN;
      k4[t] = *(const float4*)(z + 2304 + c);
      kk[t] = make_float4(k4[t].x * kkw.x, k4[t].y * kkw.y, k4[t].z * kkw.z, k4[t].w * kkw.w);
      float ss = kk[t].x * kk[t].x + kk[t].y * kk[t].y + kk[t].z * kk[t].z + kk[t].w * kk[t].w;
      ss = sum16(ss);
      const float inv = rsqrtf(ss + EPS);
      kk[t].x *= inv; kk[t].y *= inv; kk[t].z *= inv; kk[t].w *= inv;
      tw[t] = tanhf(z[2816 + lane]);
      al[t] = z[2880 + lane];
      *(float4*)(p.PREP + (size_t)(tok0 + t) * NPREP + c) = kk[t];
    }
#pragma unroll
    for (int dir = 0; dir < 2; ++dir) {
      const float4 w0v = *(const float4*)(p.w0 + (l * 2 + dir) * 256 + c);
      const float4 a0v = *(const float4*)(p.a0 + (l * 2 + dir) * 256 + c);
      float4 wa[NT], aa[NT];
#pragma unroll
      for (int t = 0; t < NT; ++t) { wa[t] = w0v; aa[t] = a0v; }
      const float* w2p = p.w2 + (size_t)(l * 2 + dir) * 32 * 256 + c;
      const float* a2p = p.a2 + (size_t)(l * 2 + dir) * 32 * 256 + c;
#pragma unroll 2
      for (int r = 0; r < 32; ++r) {
        const float4 w2v = *(const float4*)(w2p + r * 256);
        const float4 a2v = *(const float4*)(a2p + r * 256);
#pragma unroll
        for (int t = 0; t < NT; ++t) {
          const float tv = bcast(tw[t], dir * 32 + r), av = bcast(al[t], dir * 32 + r);
          wa[t].x += tv * w2v.x; wa[t].y += tv * w2v.y; wa[t].z += tv * w2v.z; wa[t].w += tv * w2v.w;
          aa[t].x += av * a2v.x; aa[t].y += av * a2v.y; aa[t].z += av * a2v.z; aa[t].w += av * a2v.w;
        }
      }
      const float ce = -0.6065306597126334f;
#pragma unroll
      for (int t = 0; t < NT; ++t) {
        float* pr = p.PREP + (size_t)(tok0 + t) * NPREP;
        float4 dec = make_float4(__expf(ce * sigmoidf_(wa[t].x)), __expf(ce * sigmoidf_(wa[t].y)),
                                 __expf(ce * sigmoidf_(wa[t].z)), __expf(ce * sigmoidf_(wa[t].w)));
        float4 a = make_float4(sigmoidf_(aa[t].x), sigmoidf_(aa[t].y), sigmoidf_(aa[t].z), sigmoidf_(aa[t].w));
        *(float4*)(pr + (1 + 2 * dir) * 256 + c) = dec;
        *(float4*)(pr + (2 + 2 * dir) * 256 + c) = a;
      }
    }
  }
}

__device__ void scan_item(const P& p, int l, int item, char* smem) {
  const int tid = otid(), lane = tid & 63, wid = tid >> 6;
  const bool lat = item < 64;
  const int j = lat ? item : item - 64;
  const int quarter = j & 3, dir = (j >> 2) & 1, h = (j >> 3) & 3, b = j >> 5;
  const int T = lat ? 1024 : 256;
  const int base = lat ? NCTX + b * 1024 : b * 256;
  const int kq = lane & 15, v = quarter * 16 + wid * 4 + (lane >> 4);
  float* buf = (float*)smem;
  f32x2 S01 = {0.f, 0.f}, S23 = {0.f, 0.f};
  if (lat) {
    const float* sp = p.state + ((((size_t)(b * 2 + l) * 2 + dir) * 4 + h) * 64 + v) * 64 + kq * 4;
    const float4 s0 = *(const float4*)sp;
    S01.x = s0.x; S01.y = s0.y; S23.x = s0.z; S23.y = s0.w;
  }
  const int nch = T >> 4;
  const int lst = tid >> 4, lc4 = tid & 15;
  const int lcol = h * 64 + lc4 * 4;
  const float4 ka4 = *(const float4*)(p.k_a + l * 256 + lcol);
  float4 x0, x1, x2, x3, x4, x5, y0, y1, y2, y3, y4, y5;
#define SLOAD(G, cb)                                                                                \
  {                                                                                                 \
    const int tl_ = (cb) + lst;                                                                     \
    const int tok_ = base + (dir ? T - 1 - tl_ : tl_);                                              \
    const float* zr_ = p.Z + (size_t)tok_ * DIN + lcol;                                             \
    const float* pr_ = p.PREP + (size_t)tok_ * NPREP + lcol;                                        \
    G##0 = *(const float4*)(zr_ + 2048);                                                            \
    G##1 = *(const float4*)(pr_ + (1 + 2 * dir) * 256);                                             \
    G##2 = *(const float4*)(zr_ + 2304);                                                            \
    G##3 = *(const float4*)(pr_);                                                                   \
    G##4 = *(const float4*)(pr_ + (2 + 2 * dir) * 256);                                             \
    G##5 = *(const float4*)(zr_ + 2560);                                                            \
  }
#define SSTORE(G, dst)                                                                              \
  {                                                                                                 \
    float* d_ = (dst) + lst * 384 + lc4 * 4;                                                        \
    const float4 k_ = G##2, n_ = G##3, s_ = G##4;                                                   \
    *(float4*)(d_) = G##0; *(float4*)(d_ + 64) = G##1;                                              \
    *(float4*)(d_ + 128) = make_float4(k_.x * (1.f + (s_.x - 1.f) * ka4.x), k_.y * (1.f + (s_.y - 1.f) * ka4.y), \
                                       k_.z * (1.f + (s_.z - 1.f) * ka4.z), k_.w * (1.f + (s_.w - 1.f) * ka4.w)); \
    *(float4*)(d_ + 192) = make_float4(-n_.x, -n_.y, -n_.z, -n_.w);                                 \
    *(float4*)(d_ + 256) = make_float4(n_.x * s_.x, n_.y * s_.y, n_.z * s_.z, n_.w * s_.w);         \
    *(float4*)(d_ + 320) = G##5;                                                                    \
  }
  __syncthreads();
  SLOAD(x, 0)
  SSTORE(x, buf)
  __syncthreads();
  SLOAD(x, 16)
  SLOAD(y, 32)
  float* yb = p.Y + (size_t)dir * NTOK * 256 + h * 64 + v;
  const int kq4 = kq * 4;
  float ykeep = 0.f;
#define SI_LOAD(P_, bs_)                                                                               \
  P_##r = *(const f32x4*)((bs_) + kq4); P_##w = *(const f32x4*)((bs_) + 64 + kq4);                     \
  P_##k = *(const f32x4*)((bs_) + 128 + kq4); P_##a = *(const f32x4*)((bs_) + 192 + kq4);              \
  P_##b = *(const f32x4*)((bs_) + 256 + kq4); P_##vv = (bs_)[320 + v];
#define SI_DECL(P_) f32x4 P_##r, P_##w, P_##k, P_##a, P_##b; float P_##vv;
#define LO2(x) __builtin_shufflevector(x, x, 0, 1)
#define HI2(x) __builtin_shufflevector(x, x, 2, 3)
#define SI_STEP(P_, st_)                                                                               \
  {                                                                                                    \
    f32x2 t1 = S01 * LO2(P_##a); t1 = S23 * HI2(P_##a) + t1;                                           \
    const float sa = sum16(t1.x + t1.y);                                                               \
    const f32x2 sa2 = {sa, sa}, vv2 = {P_##vv, P_##vv};                                                \
    S01 = S01 * LO2(P_##w) + (sa2 * LO2(P_##b) + vv2 * LO2(P_##k));                                    \
    S23 = S23 * HI2(P_##w) + (sa2 * HI2(P_##b) + vv2 * HI2(P_##k));                                    \
    f32x2 u1 = S01 * LO2(P_##r); u1 = S23 * HI2(P_##r) + u1;                                           \
    const float y = sum16(u1.x + u1.y);                                                                \
    ykeep = (kq == (st_)) ? y : ykeep;                                                                 \
  }
  SI_DECL(e_) SI_DECL(o_) SI_DECL(t_)
  __builtin_amdgcn_s_setprio(3);
#define CHUNK_STEPS(cb_, ch_)                                                                          \
  {                                                                                                    \
    SI_LOAD(e_, cb_)                                                                                   \
    SI_LOAD(o_, (cb_) + 384)                                                                           \
    SI_LOAD(t_, (cb_) + 2 * 384)                                                                   \
    SI_STEP(e_, 0)                                                                                    \
    SI_LOAD(e_, (cb_) + 3 * 384)                                                                   \
    SI_STEP(o_, 1)                                                                                    \
    SI_LOAD(o_, (cb_) + 4 * 384)                                                                   \
    SI_STEP(t_, 2)                                                                                    \
    SI_LOAD(t_, (cb_) + 5 * 384)                                                                   \
    SI_STEP(e_, 3)                                                                                    \
    SI_LOAD(e_, (cb_) + 6 * 384)                                                                   \
    SI_STEP(o_, 4)                                                                                    \
    SI_LOAD(o_, (cb_) + 7 * 384)                                                                   \
    SI_STEP(t_, 5)                                                                                    \
    SI_LOAD(t_, (cb_) + 8 * 384)                                                                   \
    SI_STEP(e_, 6)                                                                                    \
    SI_LOAD(e_, (cb_) + 9 * 384)                                                                   \
    SI_STEP(o_, 7)                                                                                    \
    SI_LOAD(o_, (cb_) + 10 * 384)                                                                   \
    SI_STEP(t_, 8)                                                                                    \
    SI_LOAD(t_, (cb_) + 11 * 384)                                                                   \
    SI_STEP(e_, 9)                                                                                    \
    SI_LOAD(e_, (cb_) + 12 * 384)                                                                   \
    SI_STEP(o_, 10)                                                                                    \
    SI_LOAD(o_, (cb_) + 13 * 384)                                                                   \
    SI_STEP(t_, 11)                                                                                    \
    SI_LOAD(t_, (cb_) + 14 * 384)                                                                   \
    SI_STEP(e_, 12)                                                                                    \
    SI_LOAD(e_, (cb_) + 15 * 384)                                                                   \
    SI_STEP(o_, 13)                                                                                    \
    SI_STEP(t_, 14)                                                                                    \
    SI_STEP(e_, 15)                                                                                    \
    const int tl = (ch_) * 16 + kq;                                                                    \
    const int tok = base + (dir ? T - 1 - tl : tl);                                                    \
    yb[(size_t)tok * 256] = ykeep;                                                                     \
  }
  float* buf1 = buf + 16 * 384;
  for (int ch = 0; ch < nch; ch += 2) {
    CHUNK_STEPS(buf, ch)
    SSTORE(x, buf1)
    __syncthreads();
    if (ch + 3 < nch) { SLOAD(x, (ch + 3) * 16) }
    CHUNK_STEPS(buf1, ch + 1)
    if (ch + 2 < nch) { SSTORE(y, buf) }
    __syncthreads();
    if (ch + 4 < nch) { SLOAD(y, (ch + 4) * 16) }
  }
#undef CHUNK_STEPS
  __builtin_amdgcn_s_setprio(0);
#undef SI_LOAD
#undef SI_DECL
#undef SI_STEP
#undef LO2
#undef HI2
#undef SLOAD
#undef SSTORE
  if (!lat) {
    float* dp = p.out_state + ((((size_t)(b * 2 + l) * 2 + dir) * 4 + h) * 64 + v) * 64 + kq * 4;
    *(float4*)dp = make_float4(S01.x, S01.y, S23.x, S23.y);
  }
}

__device__ void scan_item8(const P& p, int l, int item, char* smem) {
  const int tid = otid(), lane = tid & 63, wid = tid >> 6;
  const bool lat = false;
  const int j = item;
  const int half = j & 1, dir = (j >> 1) & 1, h = (j >> 2) & 3, b = j >> 4;
  const int T = lat ? 1024 : 256;
  const int base = lat ? NCTX + b * 1024 : b * 256;
  const int kq = lane & 7, v = half * 32 + wid * 8 + (lane >> 3);
  float* buf = (float*)smem;
  float S[8];
  if (lat) {
    const float* sp = p.state + ((((size_t)(b * 2 + l) * 2 + dir) * 4 + h) * 64 + v) * 64 + kq * 8;
    float4 s0 = *(const float4*)sp, s1 = *(const float4*)(sp + 4);
    S[0] = s0.x; S[1] = s0.y; S[2] = s0.z; S[3] = s0.w; S[4] = s1.x; S[5] = s1.y; S[6] = s1.z; S[7] = s1.w;
  } else {
#pragma unroll
    for (int i = 0; i < 8; ++i) S[i] = 0.f;
  }
  const int nch = T >> 4;
  const int lst = tid >> 4, lc4 = tid & 15;
  const int lcol = h * 64 + lc4 * 4;
  const float4 ka4 = *(const float4*)(p.k_a + l * 256 + lcol);
  float4 g0, g1, g2, g3, g4, g5;
#define SLOAD(cb)                                                                                   \
  {                                                                                                 \
    const int tl_ = (cb) + lst;                                                                     \
    const int tok_ = base + (dir ? T - 1 - tl_ : tl_);                                              \
    const float* zr_ = p.Z + (size_t)tok_ * DIN + lcol;                                             \
    const float* pr_ = p.PREP + (size_t)tok_ * NPREP + lcol;                                        \
    g0 = *(const float4*)(zr_ + 2048);                                                              \
    g1 = *(const float4*)(pr_ + (1 + 2 * dir) * 256);                                               \
    g2 = *(const float4*)(zr_ + 2304);                                                              \
    g3 = *(const float4*)(pr_);                                                                     \
    g4 = *(const float4*)(pr_ + (2 + 2 * dir) * 256);                                               \
    g5 = *(const float4*)(zr_ + 2560);                                                              \
  }
#define SSTORE(dst)                                                                                 \
  {                                                                                                 \
    float* d_ = (dst) + lst * 384 + lc4 * 4;                                                        \
    *(float4*)(d_) = g0; *(float4*)(d_ + 64) = g1;                                                  \
    *(float4*)(d_ + 128) = make_float4(g2.x * (1.f + (g4.x - 1.f) * ka4.x), g2.y * (1.f + (g4.y - 1.f) * ka4.y), \
                                       g2.z * (1.f + (g4.z - 1.f) * ka4.z), g2.w * (1.f + (g4.w - 1.f) * ka4.w)); \
    *(float4*)(d_ + 192) = make_float4(-g3.x, -g3.y, -g3.z, -g3.w);                                 \
    *(float4*)(d_ + 256) = make_float4(g3.x * g4.x, g3.y * g4.y, g3.z * g4.z, g3.w * g4.w);         \
    *(float4*)(d_ + 320) = g5;                                                                      \
  }
  __syncthreads();
  SLOAD(0)
  SSTORE(buf)
  __syncthreads();
  float* yb = p.Y + (size_t)dir * NTOK * 256 + h * 64 + v;
  const int kq8 = kq * 8;
  float ykeep = 0.f;
#define SI_LOAD(P_, bs_)                                                                               \
  P_##r0 = *(const f32x4*)((bs_) + kq8); P_##r1 = *(const f32x4*)((bs_) + kq8 + 4);                    \
  P_##w0 = *(const f32x4*)((bs_) + 64 + kq8); P_##w1 = *(const f32x4*)((bs_) + 64 + kq8 + 4);          \
  P_##k0 = *(const f32x4*)((bs_) + 128 + kq8); P_##k1 = *(const f32x4*)((bs_) + 128 + kq8 + 4);        \
  P_##a0 = *(const f32x4*)((bs_) + 192 + kq8); P_##a1 = *(const f32x4*)((bs_) + 192 + kq8 + 4);        \
  P_##b0 = *(const f32x4*)((bs_) + 256 + kq8); P_##b1 = *(const f32x4*)((bs_) + 256 + kq8 + 4);        \
  P_##vv = (bs_)[320 + v];
#define SI_DECL(P_) f32x4 P_##r0, P_##r1, P_##w0, P_##w1, P_##k0, P_##k1, P_##a0, P_##a1, P_##b0, P_##b1; float P_##vv;
#define LO2(x) __builtin_shufflevector(x, x, 0, 1)
#define HI2(x) __builtin_shufflevector(x, x, 2, 3)
#define SI_STEP(P_, st_)                                                                               \
  {                                                                                                    \
    f32x2 t1 = S01 * LO2(P_##a0); t1 = S23 * HI2(P_##a0) + t1;                                         \
    f32x2 t2 = S45 * LO2(P_##a1); t2 = S67 * HI2(P_##a1) + t2;                                         \
    t1 = t1 + t2;                                                                                      \
    float sa = sum8(t1.x + t1.y);                                                                      \
    const f32x2 sa2 = {sa, sa}, vv2 = {P_##vv, P_##vv};                                                \
    S01 = S01 * LO2(P_##w0) + (sa2 * LO2(P_##b0) + vv2 * LO2(P_##k0));                                 \
    S23 = S23 * HI2(P_##w0) + (sa2 * HI2(P_##b0) + vv2 * HI2(P_##k0));                                 \
    S45 = S45 * LO2(P_##w1) + (sa2 * LO2(P_##b1) + vv2 * LO2(P_##k1));                                 \
    S67 = S67 * HI2(P_##w1) + (sa2 * HI2(P_##b1) + vv2 * HI2(P_##k1));                                 \
    f32x2 u1 = S01 * LO2(P_##r0); u1 = S23 * HI2(P_##r0) + u1;                                         \
    f32x2 u2 = S45 * LO2(P_##r1); u2 = S67 * HI2(P_##r1) + u2;                                         \
    u1 = u1 + u2;                                                                                      \
    const float y = sum8(u1.x + u1.y);                                                                 \
    ykeep = (kq == ((st_)&7)) ? y : ykeep;                                                             \
    if (((st_)&7) == 7) {                                                                              \
      const int tl = ch * 16 + ((st_)&8) + kq;                                                         \
      const int tok = base + (dir ? T - 1 - tl : tl);                                                  \
      yb[(size_t)tok * 256] = ykeep;                                                                   \
    }                                                                                                  \
  }
  f32x2 S01 = {S[0], S[1]}, S23 = {S[2], S[3]}, S45 = {S[4], S[5]}, S67 = {S[6], S[7]};
  SI_DECL(e_) SI_DECL(o_)
  __builtin_amdgcn_s_setprio(2);
  for (int ch = 0; ch < nch; ++ch) {
    const int cur = ch & 1;
    if (ch + 1 < nch) { SLOAD((ch + 1) * 16) }
    const float* cb = buf + cur * (16 * 384);
    SI_LOAD(e_, cb)
#pragma unroll 1
    for (int st = 0; st < 16; st += 2) {
      SI_LOAD(o_, cb + (st + 1) * 384)
      SI_STEP(e_, st)
      if (st + 2 < 16) { SI_LOAD(e_, cb + (st + 2) * 384) }
      SI_STEP(o_, st + 1)
    }
    if (ch + 1 < nch) {
      float* nb = buf + (cur ^ 1) * (16 * 384);
      SSTORE(nb)
    }
    __syncthreads();
  }
  __builtin_amdgcn_s_setprio(0);
#undef SI_LOAD
#undef SI_DECL
#undef SI_STEP
#undef LO2
#undef HI2
  S[0] = S01.x; S[1] = S01.y; S[2] = S23.x; S[3] = S23.y; S[4] = S45.x; S[5] = S45.y; S[6] = S67.x; S[7] = S67.y;
#undef SLOAD
#undef SSTORE
  if (!lat) {
    float* dp = p.out_state + ((((size_t)(b * 2 + l) * 2 + dir) * 4 + h) * 64 + v) * 64 + kq * 8;
    *(float4*)dp = make_float4(S[0], S[1], S[2], S[3]);
    *(float4*)(dp + 4) = make_float4(S[4], S[5], S[6], S[7]);
  }
}

__device__ void attn_unit(const P& p, int l, int unit, char* smem) {
  const int tid = otid(), lane = tid & 63, wid = tid >> 6;
  const int fr = lane & 15, fq = lane >> 4;
  char* sK = smem;
  bfraw* sVt = (bfraw*)(smem + 16384);
  bfraw* sP = (bfraw*)(smem + 16384 + 17408);
  float* sRpb = (float*)(smem + 16384 + 2 * 17408);
  const bool na = unit >= 1024;
  int b, h, qtok0, r = 0, rs = 0;
  __syncthreads();
  if (!na) { const int qb = unit & 3; h = (unit >> 2) & 7; b = unit >> 5; qtok0 = b * 256 + qb * 64; }
  else {
    const int u = unit - 1024; r = u & 15; h = (u >> 4) & 7; b = u >> 7;
    qtok0 = NCTX + b * 1024 + r * 64; rs = min(max(r - 4, 0), 8);
    for (int i = tid; i < 465; i += 256) sRpb[i] = p.rpb[(size_t)(l * 8 + h) * 465 + i];
  }
  bf16x8 qf[2];
  {
    const bfraw* qp = p.QB + (size_t)(qtok0 + wid * 16 + fr) * 512 + h * 64 + fq * 8;
#pragma unroll
    for (int s = 0; s < 2; ++s) qf[s] = as_bf8(*(const uint4*)(qp + s * 32));
  }
  float m_run[4], l_run[4];
  f32x4 o[4];
#pragma unroll
  for (int j = 0; j < 4; ++j) { m_run[j] = -1e30f; l_run[j] = 0.f; o[j] = (f32x4){0.f, 0.f, 0.f, 0.f}; }
  const int nseg = na ? 6 : 2;
  const int sw = (fr >> 1) & 7;
  for (int seg = 0; seg < nseg; ++seg) {
    const float *kbase, *vbase;
    int kstride, krow0 = 0;
    bool local = false;
    if (!na) {
      const size_t i0 = ((size_t)(b * 2 + l) * 256 + seg * 128) * 512 + h * 64;
      kbase = p.out_k + i0; vbase = p.out_v + i0; kstride = 512;
    } else if (seg < 2) {
      const size_t i0 = ((size_t)(b * 2 + l) * 256 + seg * 128) * 512 + h * 64;
      kbase = p.cache_k + i0; vbase = p.cache_v + i0; kstride = 512;
    } else {
      krow0 = rs + 2 * (seg - 2);
      const size_t t0 = (size_t)(NCTX + b * 1024 + krow0 * 64) * DIN + h * 64;
      kbase = p.Z + t0 + 512; vbase = p.Z + t0 + 1024; kstride = DIN; local = true;
    }
    __syncthreads();
    {
      const int key = tid >> 1, hf = tid & 1;
      const float* kp = kbase + (size_t)key * kstride + hf * 32;
      const float* vp = vbase + (size_t)key * kstride + hf * 32;
#pragma unroll
      for (int c = 0; c < 4; ++c) {
        float4 x0 = *(const float4*)(kp + c * 8), x1 = *(const float4*)(kp + c * 8 + 4);
        const int chunk = hf * 4 + c;
        *(uint4*)(sK + key * 128 + ((chunk ^ ((key >> 1) & 7)) << 4)) = pack8(x0, x1);
      }
#pragma unroll
      for (int c = 0; c < 8; ++c) {
        float4 x = *(const float4*)(vp + c * 4);
        bfraw* d = sVt + (hf * 8 + c) * 136 + key;
        d[0] = (bfraw)f2bf(x.x); d[16 * 136] = (bfraw)f2bf(x.y); d[32 * 136] = (bfraw)f2bf(x.z); d[48 * 136] = (bfraw)f2bf(x.w);
      }
    }
    __syncthreads();
    f32x4 s[8];
#pragma unroll
    for (int n = 0; n < 8; ++n) {
      f32x4 acc = (f32x4){0.f, 0.f, 0.f, 0.f};
#pragma unroll
      for (int ks = 0; ks < 2; ++ks) {
        bf16x8 kf = *(const bf16x8*)(sK + (n * 16 + fr) * 128 + (((ks * 4 + fq) ^ sw) << 4));
        acc = mfma16(qf[ks], kf, acc);
      }
      s[n] = acc;
    }
#pragma unroll
    for (int n = 0; n < 8; ++n)
#pragma unroll
      for (int j = 0; j < 4; ++j) {
        float v = s[n][j] * 0.125f;
        if (local) {
          const int qc = wid * 16 + fq * 4 + j;
          const int kidx = n * 16 + fr;
          const int krow = krow0 + (kidx >> 6), kc = kidx & 63;
          const int cs = min(max(qc - 8, 0), 48);
          const bool ok = (kc >= cs) && (kc < cs + 16);
          const int dr = krow - r + 7;
          const int dc = min(max(kc - qc + 15, 0), 30);
          const float bias = sRpb[dr * 31 + dc];
          v = ok ? v + bias : -1e30f;
        }
        s[n][j] = v;
      }
#pragma unroll
    for (int j = 0; j < 4; ++j) {
      float mx = s[0][j];
#pragma unroll
      for (int n = 1; n < 8; ++n) mx = fmaxf(mx, s[n][j]);
      mx = max16(mx);
      const float mn = fmaxf(m_run[j], mx);
      const float alpha = __expf(m_run[j] - mn);
      float sum = 0.f;
#pragma unroll
      for (int n = 0; n < 8; ++n) { float pv = __expf(s[n][j] - mn); s[n][j] = pv; sum += pv; }
      sum = sum16(sum);
      l_run[j] = l_run[j] * alpha + sum;
      m_run[j] = mn;
#pragma unroll
      for (int n = 0; n < 4; ++n) o[n][j] *= alpha;
    }
#pragma unroll
    for (int n = 0; n < 8; ++n)
#pragma unroll
      for (int j = 0; j < 4; ++j) sP[(wid * 16 + fq * 4 + j) * 136 + n * 16 + fr] = (bfraw)f2bf(s[n][j]);
    __syncthreads();
#pragma unroll
    for (int ks = 0; ks < 4; ++ks) {
      bf16x8 pf = *(const bf16x8*)(sP + (wid * 16 + fr) * 136 + ks * 32 + fq * 8);
#pragma unroll
      for (int n = 0; n < 4; ++n) {
        bf16x8 vf = *(const bf16x8*)(sVt + (n * 16 + fr) * 136 + ks * 32 + fq * 8);
        o[n] = mfma16(pf, vf, o[n]);
      }
    }
  }
#pragma unroll
  for (int j = 0; j < 4; ++j) {
    const float inv = 1.f / l_run[j];
    uint2 ov; ov.x = pack2(o[0][j] * inv, o[1][j] * inv); ov.y = pack2(o[2][j] * inv, o[3][j] * inv);
    *(uint2*)(p.O + (size_t)(qtok0 + wid * 16 + fq * 4 + j) * D + h * 64 + 4 * fr) = ov;
  }
}

__device__ void sgu_unit(const P& p, int l, int unit, char* smem) {
  const int tid = otid(), lane = tid & 63, wid = tid >> 6;
  const int fr = lane & 15, fq = lane >> 4;
  const int g = unit & 3, chunk = unit >> 2;
  const int tok0 = chunk * 128;
  char* sA = smem;
  bfraw* sVn = (bfraw*)(smem + 32768);
  float* sStat = (float*)(smem + 32768 + 17408);
  __syncthreads();
  {
    const int q = tid >> 1, hf = tid & 1;
    const uint4* vp = (const uint4*)(p.UB + (size_t)(tok0 + q) * 512 + 256 + hf * 128);
    float s1 = 0.f, s2 = 0.f;
#pragma unroll 8
    for (int i = 0; i < 16; ++i) {
      float4 xa, xb2;
      unpack8(vp[i], xa, xb2);
      s1 += ((xa.x + xa.y) + (xa.z + xa.w)) + ((xb2.x + xb2.y) + (xb2.z + xb2.w));
      s2 += ((xa.x * xa.x + xa.y * xa.y) + (xa.z * xa.z + xa.w * xa.w)) + ((xb2.x * xb2.x + xb2.y * xb2.y) + (xb2.z * xb2.z + xb2.w * xb2.w));
    }
    s1 += dpp<0xB1>(s1); s2 += dpp<0xB1>(s2);
    const float mu = s1 * (1.f / 256.f);
    const float var = fmaxf(s2 * (1.f / 256.f) - mu * mu, 0.f);
    const float rstd = rsqrtf(var + EPS);
    const uint4* gp = (const uint4*)(p.UB + (size_t)(tok0 + q) * 512 + 256 + g * 64 + hf * 32);
    const float* lw = p.sgu_ln_w + l * 256 + g * 64 + hf * 32;
    const float* lb = p.sgu_ln_b + l * 256 + g * 64 + hf * 32;
#pragma unroll
    for (int c = 0; c < 4; ++c) {
      float4 x0, x1;
      unpack8(gp[c], x0, x1);
#pragma unroll
      for (int e2 = 0; e2 < 2; ++e2) {
        const float4 x = e2 ? x1 : x0;
        const float4 w = *(const float4*)(lw + c * 8 + e2 * 4), bb = *(const float4*)(lb + c * 8 + e2 * 4);
        bfraw* d = sVn + (hf * 8 + c * 2 + e2) * 136 + q;
        d[0] = (bfraw)f2bf((x.x - mu) * rstd * w.x + bb.x);
        d[16 * 136] = (bfraw)f2bf((x.y - mu) * rstd * w.y + bb.y);
        d[32 * 136] = (bfraw)f2bf((x.z - mu) * rstd * w.z + bb.z);
        d[48 * 136] = (bfraw)f2bf((x.w - mu) * rstd * w.w + bb.w);
      }
    }
    const float* wsrc = p.sgu_w_s + (size_t)(l * 4 + g) * 128 * 128;
    const int prow = tid >> 1;
#pragma unroll
    for (int c = 0; c < 8; ++c) {
      const int chunkc = hf * 8 + c;
      float4 x0 = *(const float4*)(wsrc + prow * 128 + chunkc * 8), x1 = *(const float4*)(wsrc + prow * 128 + chunkc * 8 + 4);
      *(uint4*)(sA + prow * 256 + ((chunkc ^ (prow & 15)) << 4)) = pack8(x0, x1);
    }
    (void)sStat;
  }
  __syncthreads();
  f32x4 acc[2][4];
#pragma unroll
  for (int m = 0; m < 2; ++m)
#pragma unroll
    for (int n = 0; n < 4; ++n) acc[m][n] = (f32x4){0.f, 0.f, 0.f, 0.f};
#pragma unroll
  for (int ks = 0; ks < 4; ++ks) {
    bf16x8 af[2], bf[4];
#pragma unroll
    for (int m = 0; m < 2; ++m) {
      const int row = wid * 32 + m * 16 + fr;
      af[m] = *(const bf16x8*)(sA + row * 256 + (((ks * 4 + fq) ^ (row & 15)) << 4));
    }
#pragma unroll
    for (int n = 0; n < 4; ++n) bf[n] = *(const bf16x8*)(sVn + (n * 16 + fr) * 136 + ks * 32 + fq * 8);
#pragma unroll
    for (int m = 0; m < 2; ++m)
#pragma unroll
      for (int n = 0; n < 4; ++n) acc[m][n] = mfma16(af[m], bf[n], acc[m][n]);
  }
#pragma unroll
  for (int m = 0; m < 2; ++m)
#pragma unroll
    for (int j = 0; j < 4; ++j) {
      const int pr = wid * 32 + m * 16 + fq * 4 + j;
      const float bs = p.sgu_b_s[(l * 4 + g) * 128 + pr];
      const uint2 ub = *(const uint2*)(p.UB + (size_t)(tok0 + pr) * 512 + g * 64 + 4 * fr);
      const float4 u = make_float4(__uint_as_float(ub.x << 16), __uint_as_float(ub.x & 0xffff0000u), __uint_as_float(ub.y << 16),
                                   __uint_as_float(ub.y & 0xffff0000u));
      uint2 ov; ov.x = pack2(u.x * (acc[m][0][j] + bs), u.y * (acc[m][1][j] + bs));
      ov.y = pack2(u.z * (acc[m][2][j] + bs), u.w * (acc[m][3][j] + bs));
      *(uint2*)(p.O + (size_t)(tok0 + pr) * D + 512 + g * 64 + 4 * fr) = ov;
    }
}

__device__ void phase_mixer(const P& p, int l, char* smem, int* s_item, int rep) {
  const int nitems = 576 + 256 + 1024 + 320 + ((l == 0 && rep == 0) ? N_LATE_T : 0);
  unsigned* ctr = p.bar + XCD_BAR_WORDS + 16 * l + 4 * rep;
  for (;;) {
    __syncthreads();
    if (otid() == 0) *s_item = (int)atomicAdd(ctr, 1u);
    __syncthreads();
    const int i = *s_item;
    if (i >= nitems) break;
    if (i < 64) scan_item(p, l, i, smem);
    else if (i < 576) scan_item8(p, l, i - 64, smem);
    else if (i < 832) attn_unit(p, l, 1024 + (i - 576), smem);
    else if (i < 1856) attn_unit(p, l, i - 832, smem);
    else if (i < 2176) sgu_unit(p, l, i - 1856, smem);
    else transpose_item(p, late_transpose_id(i - 2176), smem);
  }
}

__device__ void phase_post(const P& p, int l) {
  constexpr int NT = 4;
  const int lane = otid() & 63;
  const int gw = (obid() * 256 + otid()) >> 6, nw = gridDim.x * 4;
  const int c = lane * 4;
  const float4 lnw = *(const float4*)(p.ln_w + l * 256 + c);
  const float4 lnb = *(const float4*)(p.ln_b + l * 256 + c);
  const float4 rkw = *(const float4*)(p.r_k + l * 256 + c);
  const float* g2p = p.g2 + (size_t)l * 64 * 256 + c;
  for (int tok0 = gw * NT; tok0 < NTOK; tok0 += nw * NT) {
    float sg[NT];
    float4 g[NT];
#pragma unroll
    for (int t = 0; t < NT; ++t) {
      sg[t] = sigmoidf_(p.Z[(size_t)(tok0 + t) * DIN + 2944 + lane]);
      g[t] = make_float4(0.f, 0.f, 0.f, 0.f);
    }
#pragma unroll 4
    for (int r = 0; r < 64; ++r) {
      const float4 w = *(const float4*)(g2p + r * 256);
#pragma unroll
      for (int t = 0; t < NT; ++t) {
        const float sv = bcast(sg[t], r);
        g[t].x += sv * w.x; g[t].y += sv * w.y; g[t].z += sv * w.z; g[t].w += sv * w.w;
      }
    }
#pragma unroll
    for (int t = 0; t < NT; ++t) {
      const int tok = tok0 + t;
      const float* z = p.Z + (size_t)tok * DIN;
      const float4 yf = *(const float4*)(p.Y + (size_t)tok * 256 + c);
      const float4 yb = *(const float4*)(p.Y + (size_t)(NTOK + tok) * 256 + c);
      float4 y = make_float4(yf.x + yb.x, yf.y + yb.y, yf.z + yb.z, yf.w + yb.w);
      const float s1 = sum16((y.x + y.y) + (y.z + y.w));
      const float mu = s1 * (1.f / 64.f);
      y.x -= mu; y.y -= mu; y.z -= mu; y.w -= mu;
      const float s2 = sum16((y.x * y.x + y.y * y.y) + (y.z * y.z + y.w * y.w));
      const float rstd = rsqrtf(s2 * (1.f / 64.f) + GN_EPS);
      const float4 r4 = *(const float4*)(z + 2048 + c);
      const float4 k4 = *(const float4*)(z + 2304 + c);
      const float4 v4 = *(const float4*)(z + 2560 + c);
      const float rk = sum16((r4.x * k4.x * rkw.x + r4.y * k4.y * rkw.y) + (r4.z * k4.z * rkw.z + r4.w * k4.w * rkw.w));
      const float o0 = (y.x * rstd * lnw.x + lnb.x + rk * v4.x) * g[t].x;
      const float o1 = (y.y * rstd * lnw.y + lnb.y + rk * v4.y) * g[t].y;
      const float o2 = (y.z * rstd * lnw.z + lnb.z + rk * v4.z) * g[t].z;
      const float o3 = (y.w * rstd * lnw.w + lnb.w + rk * v4.w) * g[t].w;
      uint2 ov; ov.x = pack2(o0, o1); ov.y = pack2(o2, o3);
      *(uint2*)(p.O + (size_t)tok * D + 768 + c) = ov;
    }
  }
}

constexpr int NPHASE = 26;

__global__ void __launch_bounds__(256, 3) mk(P p, int ph_lo, int ph_hi) {
  __shared__ __attribute__((aligned(16))) char smem[53248];
  __shared__ uint4 xb_words;
  __shared__ int s_item;
  cg::grid_group grid = cg::this_grid();
  if (ph_hi < 0) grid.sync();
  if (threadIdx.x == 0) xb_words = make_uint4(0u, 0u, 0u, 0u);
  __syncthreads();
  XcdBarrier xb;
  xb.bar = p.bar; xb.x = 0; xb.st = (volatile LAS unsigned*)&xb_words;
  if (ph_hi - ph_lo > 1) xb = xcd_barrier_post(p.bar, (volatile LAS unsigned*)&xb_words);
#define RUN(idx, ...)                                   \
  if (ph_lo <= (idx) && (idx) < ph_hi) {                \
    __VA_ARGS__;                                        \
    if ((idx) + 1 < ph_hi) xcd_barrier(xb);             \
  }
#define RUNS(slot, idx, ...)                                                  \
  if (ph_lo <= (idx) && (idx) < ph_hi) {                                      \
    const int nrep = 1 + (((REPMASK) >> (slot)) & 1);                         \
    for (int rep = 0; rep < nrep; ++rep) {                                    \
      __VA_ARGS__;                                                            \
      if (rep + 1 < nrep || (idx) + 1 < ph_hi) xcd_barrier(xb);               \
    }                                                                         \
  }
  RUN(0, phase_prologue(p, smem, &s_item))
  RUN(1, phase_rowop(p, 0, -1, 0, 0))
  for (int l = 0; l < 2; ++l) {
    const int pb = 2 + 12 * l;
    RUNS(0, pb + 0, phase_gemm<EPI_SWIGLU>(p, p.H, p.wt_gu + (size_t)(l * 2 + 0) * 5632 * 1024, 1024, 44, l, smem))
#if PROBE_MODE
    if (l == 0 && ph_hi - ph_lo > 1) { phase_gemm<EPI_SWIGLU, PROBE_MODE>(p, p.H, p.wt_gu, 1024, 44, l, smem); xcd_barrier(xb); }
#endif
    RUNS(1, pb + 1, phase_gemm_n1024(p, p.ACT, p.wt_down + (size_t)(l * 2 + 0) * 1024 * 2816, 2816, l, smem))
    RUN(pb + 2, phase_rowop(p, l, 0, l, 1))
    RUNS(3, pb + 3, phase_gemm<EPI_Z>(p, p.H, p.wt_in + (size_t)l * DINP * 1024, 1024, 24, l, smem))
    RUNS(4, pb + 4, phase_prep(p, l))
    RUNS(5, pb + 5, phase_mixer(p, l, smem, &s_item, rep))
    RUNS(6, pb + 6, phase_post(p, l))
    RUNS(7, pb + 7, phase_gemm_n1024(p, p.O, p.wt_out + (size_t)l * 1024 * 1024, 1024, l, smem))
    RUN(pb + 8, phase_rowop(p, l, 1, l, 2))
    RUNS(9, pb + 9, phase_gemm<EPI_SWIGLU>(p, p.H, p.wt_gu + (size_t)(l * 2 + 1) * 5632 * 1024, 1024, 44, l, smem))
    RUNS(10, pb + 10, phase_gemm_n1024(p, p.ACT, p.wt_down + (size_t)(l * 2 + 1) * 1024 * 2816, 2816, l, smem))
    RUN(pb + 11, phase_rowop(p, l, 2, l + 1, (l + 1 < 2) ? 0 : -1))
  }
#undef RUN
#undef RUNS
}

extern "C" void kernel_launch(void* const* d_in, const int* in_sizes, int n_in, void* d_out, int out_size, void* d_ws,
                              size_t ws_size, hipStream_t stream) {
  static int grid_blocks = 0;
  if (!grid_blocks) {
    int dev = 0, cus = 0, per_cu = 0;
    hipGetDevice(&dev);
    hipDeviceGetAttribute(&cus, hipDeviceAttributeMultiprocessorCount, dev);
    hipOccupancyMaxActiveBlocksPerMultiprocessor(&per_cu, mk, 256, 0);
    if (per_cu > 3) per_cu = 3;
    if (per_cu < 1) per_cu = 1;
    grid_blocks = cus * per_cu;
  }
  P p{};
  const float* const* in = (const float* const*)d_in;
  p.x_prompt = in[0]; p.x_sample = in[1]; p.cache_k = in[2]; p.cache_v = in[3]; p.state = in[4]; p.c = in[5];
  p.c_ctx = in[6]; p.w_ada = in[7]; p.b_ada = in[8]; p.norm_pre = in[9]; p.norm_post = in[10]; p.w_gu = in[11];
  p.w_down = in[12]; p.w_in = in[13]; p.w_out = in[14]; p.rpb = in[15]; p.sgu_ln_w = in[16]; p.sgu_ln_b = in[17];
  p.sgu_w_s = in[18]; p.sgu_b_s = in[19]; p.w0 = in[20]; p.w2 = in[21]; p.a0 = in[22]; p.a2 = in[23]; p.g2 = in[24];
  p.k_k = in[25]; p.k_a = in[26]; p.r_k = in[27]; p.ln_w = in[28]; p.ln_b = in[29];
  float* out = (float*)d_out;
  p.X = out;
  p.out_k = out + (size_t)NTOK * D;
  p.out_v = p.out_k + (size_t)32 * 2 * 256 * 512;
  p.out_state = p.out_v + (size_t)32 * 2 * 256 * 512;
  char* ws = (char*)d_ws;
  size_t off = 0;
  auto take = [&](size_t bytes) { char* r = ws + off; off += (bytes + 255) & ~(size_t)255; return r; };
  p.wt_gu = (bfraw*)take((size_t)4 * 5632 * 1024 * 2);
  p.wt_down = (bfraw*)take((size_t)4 * 1024 * 2816 * 2);
  p.wt_in = (bfraw*)take((size_t)2 * DINP * 1024 * 2);
  p.wt_out = (bfraw*)take((size_t)2 * 1024 * 1024 * 2);
  p.mods = (float*)take((size_t)2 * 3 * 9216 * 4);
  char* hy = take((size_t)NTOK * D * 2);
  p.H = (bfraw*)hy; p.Y = (float*)hy;
  char* u = take((size_t)NTOK * DIN * 4);
  p.Z = (float*)u; p.ACT = (bfraw*)u; p.F = (float*)(u + ((size_t)64 << 20));
  p.O = (bfraw*)take((size_t)NTOK * D * 2);
  p.PREP = (float*)take((size_t)NTOK * NPREP * 4);
  p.XB = (bfraw*)take((size_t)NTOK * D * 2);
  p.QB = (bfraw*)take((size_t)NTOK * 512 * 2);
  p.UB = (bfraw*)take((size_t)NTOK * 512 * 2);
  p.bar = (unsigned*)take((size_t)(XCD_BAR_WORDS + 64) * 4);
  if (off > ws_size) { fprintf(stderr, "workspace too small: need %zu have %zu\n", off, ws_size); return; }
  hipMemsetAsync(p.bar, 0, (size_t)(XCD_BAR_WORDS + 64) * 4, stream);
#if COOP
  int lo = 0, hi = NPHASE;
  void* args[] = {&p, &lo, &hi};
  hipError_t e = hipLaunchCooperativeKernel((void*)mk, dim3(grid_blocks), dim3(256), args, 0, stream);
  if (e != hipSuccess) fprintf(stderr, "cooperative launch failed: %s (grid %d)\n", hipGetErrorString(e), grid_blocks);
#else
  for (int ph = 0; ph < NPHASE; ++ph) mk<<<dim3(grid_blocks), dim3(256), 0, stream>>>(p, ph, ph + 1);
#endif
}
```
